# Optimizing an MI355X kernel written in HIP

```python
import math
import jax, jax.numpy as jnp
from jax import lax
import numpy as np

D_MODEL = 2048
BATCH = 2
SEQ = 8192
DEPTH = 1

HEAD_DIM = 128
N_HEADS_SB = 8
N_HEADS_DSA = 8
N_IDX_HEADS = 16
IDX_DIM = 64
TOPK_MAX = 256
D_FF = 5632
CONV_WIDTH = 3
N_BUCKETS = 32
MAX_DISTANCE = 128
Q_BLOCK = 128
EPS = 1e-6
W_SB = N_HEADS_SB * HEAD_DIM
W_DSA = N_HEADS_DSA * HEAD_DIM
IN_SIZES = (W_SB, W_SB, W_SB, W_DSA, W_DSA, W_DSA,
            N_IDX_HEADS * IDX_DIM, IDX_DIM, N_IDX_HEADS, D_MODEL, D_MODEL)
P_IN = 3 * W_SB + 3 * W_DSA + N_IDX_HEADS * IDX_DIM + IDX_DIM + N_IDX_HEADS + 2 * D_MODEL

kernel_name = 'hybrid_stickbreak_dsa_convffn_block'


def rms_norm(x, g):
    xf = x.astype(jnp.float32)
    y = xf * lax.rsqrt(jnp.mean(xf * xf, axis=-1, keepdims=True) + EPS)
    return (y * g.astype(jnp.float32)).astype(x.dtype)


def modulate(h, shift, scale):
    return h * (1.0 + scale[:, None, :]) + shift[:, None, :]


def split_columns(z):
    cuts, acc = [], 0
    for s in IN_SIZES[:-1]:
        acc += s
        cuts.append(acc)
    return jnp.split(z, cuts, axis=-1)


def rel_bucket(dist):
    n = jnp.maximum(dist, 0)
    max_exact = N_BUCKETS // 2
    nf = jnp.maximum(n, 1).astype(jnp.float32)
    large = max_exact + (jnp.log(nf / max_exact) / math.log(MAX_DISTANCE / max_exact)
                         * (N_BUCKETS - max_exact)).astype(jnp.int32)
    large = jnp.minimum(large, N_BUCKETS - 1)
    return jnp.where(n < max_exact, n, large)


def stick_breaking_attention(q, k, v):
    B, S, H, Dh = q.shape
    n_blk = S // Q_BLOCK
    kf = k.astype(jnp.float32)
    vf = v.astype(jnp.float32)
    key_pos = jnp.arange(S)
    scale = HEAD_DIM ** -0.5

    def block(i):
        start = i * Q_BLOCK
        qb = lax.dynamic_slice_in_dim(q, start, Q_BLOCK, axis=1).astype(jnp.float32)
        z = jnp.einsum('bqhd,bshd->bhqs', qb, kf) * scale
        q_pos = start + jnp.arange(Q_BLOCK)
        causal = key_pos[None, :] < q_pos[:, None]
        log_beta = jax.nn.log_sigmoid(z)
        log_keep = jnp.where(causal, jax.nn.log_sigmoid(-z), 0.0)
        suffix = lax.cumsum(log_keep, axis=3, reverse=True) - log_keep
        a = jnp.where(causal, jnp.exp(log_beta + suffix), 0.0)
        return jnp.einsum('bhqs,bshd->bqhd', a, vf)

    out = lax.map(block, jnp.arange(n_blk))
    return out.transpose(1, 0, 2, 3, 4).reshape(B, S, H * Dh).astype(q.dtype)


def indexer_sparse_attention(q, k, v, q_idx, k_idx, w_idx, rel_bias):
    B, S, H, Dh = q.shape
    n_blk = S // Q_BLOCK
    n_sel = min(TOPK_MAX, S // 4)
    kf = k.astype(jnp.float32)
    vf = v.astype(jnp.float32)
    kif = k_idx.astype(jnp.float32)
    key_pos = jnp.arange(S)
    scale = HEAD_DIM ** -0.5
    idx_scale = IDX_DIM ** -0.5
    gather = jax.vmap(lambda arr, ix: arr[ix])

    def block(i):
        start = i * Q_BLOCK
        q_pos = start + jnp.arange(Q_BLOCK)
        qi = lax.dynamic_slice_in_dim(q_idx, start, Q_BLOCK, axis=1).astype(jnp.float32)
        wi = lax.dynamic_slice_in_dim(w_idx, start, Q_BLOCK, axis=1).astype(jnp.float32)
        per_head = jax.nn.relu(jnp.einsum('bqhd,bsd->bqhs', qi, kif) * idx_scale)
        score = jnp.einsum('bqh,bqhs->bqs', wi, per_head)
        causal = key_pos[None, :] <= q_pos[:, None]
        score = jnp.where(causal[None], score, -jnp.inf)
        _, sel = lax.top_k(score, n_sel)
        valid = sel <= q_pos[None, :, None]
        k_sel = gather(kf, sel)
        v_sel = gather(vf, sel)
        qb = lax.dynamic_slice_in_dim(q, start, Q_BLOCK, axis=1).astype(jnp.float32)
        logits = jnp.einsum('bqhd,bqkhd->bhqk', qb, k_sel) * scale
        bias = rel_bias.astype(jnp.float32)[rel_bucket(q_pos[None, :, None] - sel)]
        logits = logits + bias.transpose(0, 3, 1, 2)
        logits = jnp.where(valid[:, None], logits, -jnp.inf)
        p = jax.nn.softmax(logits, axis=-1)
        return jnp.einsum('bhqk,bqkhd->bqhd', p, v_sel)

    out = lax.map(block, jnp.arange(n_blk))
    return out.transpose(1, 0, 2, 3, 4).reshape(B, S, H * Dh).astype(q.dtype)


def causal_dwconv(a, w, b):
    S = a.shape[1]
    ap = jnp.pad(a, ((0, 0), (CONV_WIDTH - 1, 0), (0, 0)))
    y = b
    for j in range(CONV_WIDTH):
        y = y + ap[:, j:j + S, :] * w[j]
    return y


def setup_inputs(seed: int = 0) -> dict:
    key = jax.random.key(seed)
    ks = jax.random.split(key, 20)
    f32 = jnp.float32

    def nrm(k, shape, fan_in):
        return jax.random.normal(k, shape, f32) * fan_in ** -0.5

    return {
        'x': jax.random.normal(ks[0], (BATCH, SEQ, D_MODEL), f32),
        'c': jax.random.normal(ks[1], (BATCH, D_MODEL), f32),
        'w_ada': 0.5 * nrm(ks[2], (DEPTH, D_MODEL, 6 * D_MODEL), D_MODEL),
        'b_ada': 0.01 * jax.random.normal(ks[3], (DEPTH, 6 * D_MODEL), f32),
        'g_mix': 1.0 + 0.05 * jax.random.normal(ks[4], (DEPTH, D_MODEL), f32),
        'w_in': nrm(ks[5], (DEPTH, D_MODEL, P_IN), D_MODEL),
        'w_o_sb': nrm(ks[6], (DEPTH, W_SB, D_MODEL), W_SB),
        'w_o_dsa': nrm(ks[7], (DEPTH, W_DSA, D_MODEL), W_DSA),
        'w_out': nrm(ks[8], (DEPTH, D_MODEL, D_MODEL), D_MODEL),
        'rel_bias': 0.5 * jax.random.normal(ks[9], (N_BUCKETS, N_HEADS_DSA), f32),
        'g_ffn': 1.0 + 0.05 * jax.random.normal(ks[10], (DEPTH, D_MODEL), f32),
        'w_gate': nrm(ks[11], (DEPTH, D_MODEL, D_FF), D_MODEL),
        'w_up': nrm(ks[12], (DEPTH, D_MODEL, D_FF), D_MODEL),
        'conv_w': nrm(ks[13], (DEPTH, CONV_WIDTH, D_FF), CONV_WIDTH),
        'conv_b': 0.01 * jax.random.normal(ks[14], (DEPTH, D_FF), f32),
        'w_down': nrm(ks[15], (DEPTH, D_FF, D_MODEL), D_FF),
        'g_final': 1.0 + 0.05 * jax.random.normal(ks[16], (D_MODEL,), f32),
    }


def reference(x, c, w_ada, b_ada, g_mix, w_in, w_o_sb, w_o_dsa, w_out, rel_bias,
              g_ffn, w_gate, w_up, conv_w, conv_b, w_down, g_final):
    B, S, _ = x.shape
    c_act = jax.nn.silu(c)
    for l in range(DEPTH):
        mod = c_act @ w_ada[l] + b_ada[l]
        sh1, sc1, gt1, sh2, sc2, gt2 = jnp.split(mod, 6, axis=-1)

        h = modulate(rms_norm(x, g_mix[l]), sh1, sc1)
        z = h @ w_in[l]
        (q_sb, k_sb, v_sb, q_ds, k_ds, v_ds, q_ix, k_ix, w_ix,
         gate_sb, gate_ds) = split_columns(z)
        hs = (B, S, N_HEADS_SB, HEAD_DIM)
        hd = (B, S, N_HEADS_DSA, HEAD_DIM)
        o_sb = stick_breaking_attention(q_sb.reshape(hs), k_sb.reshape(hs), v_sb.reshape(hs))
        o_ds = indexer_sparse_attention(
            q_ds.reshape(hd), k_ds.reshape(hd), v_ds.reshape(hd),
            q_ix.reshape(B, S, N_IDX_HEADS, IDX_DIM), k_ix,
            w_ix * (N_IDX_HEADS ** -0.5), rel_bias)
        merged = (jax.nn.sigmoid(gate_sb) * (o_sb @ w_o_sb[l])
                  + jax.nn.sigmoid(gate_ds) * (o_ds @ w_o_dsa[l]))
        x = x + gt1[:, None, :] * (merged @ w_out[l])

        h = modulate(rms_norm(x, g_ffn[l]), sh2, sc2)
        a = causal_dwconv(h @ w_gate[l], conv_w[l], conv_b[l])
        y = (jax.nn.silu(a) * (h @ w_up[l])) @ w_down[l]
        x = x + gt2[:, None, :] * y
    return rms_norm(x, g_final)
```

```cpp
#include <hip/hip_runtime.h>
#include <cstdio>
#include <cstdint>

#ifndef MK_N_LAUNCHES
#define MK_N_LAUNCHES 1
#endif

namespace pg8 {
#define PG8_LAS __attribute__((address_space(3)))
typedef unsigned short bf16_t;
typedef short bf16x8 __attribute__((ext_vector_type(8)));
typedef float f32x4 __attribute__((ext_vector_type(4)));
typedef unsigned u32x4 __attribute__((ext_vector_type(4)));
typedef unsigned u32x2 __attribute__((ext_vector_type(2)));
constexpr int BM = 256, BK = 64, HALF = 128, HTB = HALF * BK * 2  , STAGE_BYTES = 8 * HTB, NXCD = 8, WGM = 8;

__host__ __device__ __forceinline__ int lds_byte(int r, int c) { const int st = (r >> 4) * 2 + (c >> 5), rr = r & 15, cc = c & 31, ob = rr * 64 + cc * 2; return st * 1024 + (ob ^ (((ob >> 9) & 1) << 5)); }
__host__ __device__ __forceinline__ void stage_rc(int b, int& R, int& C) { const int st = b / 1024, sb = b % 1024, swz = sb ^ (((sb >> 9) & 1) << 5); R = (st >> 1) * 16 + swz / 64; C = (st & 1) * 32 + (swz % 64) / 2; }
__host__ __device__ __forceinline__ int perm32(int rho) { const int n = rho >> 4, i = rho & 15; return 8 * (i >> 2) + 4 * n + (i & 3); }

struct Unit { int pm, pn, part; };
struct Gemm { const bf16_t* A; const bf16_t* Bt; const bf16_t* A2; const bf16_t* Bt2; int K; };

struct TileOrder {
    int nM, nN, nwg, G, c, parts;
    __host__ __device__ void init(int nM_, int nN_, int parts_, int G_, int c_) { nM = nM_; nN = nN_; nwg = nM * nN; G = G_; c = c_; parts = parts_; }
    __host__ __device__ bool next(int i, Unit& u) const {
        const int ti = (parts == 2) ? (i >> 1) : i; u.part = (parts == 2) ? (i & 1) : 0;
        const long L = (long)ti * G + c; if (L >= nwg) return false;
        int wgid = (int)L; { const int q = nwg / NXCD, r = nwg % NXCD, xcd = wgid % NXCD, off = wgid / NXCD; wgid = (xcd < r ? xcd * (q + 1) : r * (q + 1) + (xcd - r) * q) + off; }
        const int nig = WGM * nN, gid = wgid / nig, fm = gid * WGM, gsz = (nM - fm) < WGM ? (nM - fm) : WGM;
        u.pm = fm + ((wgid % nig) % gsz); u.pn = (wgid % nig) / gsz; return true;
    }
};

__device__ __forceinline__ unsigned cvt_pk_bf16(float lo, float hi) { unsigned r; asm volatile("v_cvt_pk_f16_f32 %0, %1, %2" : "=v"(r) : "v"(lo), "v"(hi)); return r; }
typedef _Float16 h16x2 __attribute__((ext_vector_type(2)));
typedef _Float16 h16x8 __attribute__((ext_vector_type(8)));
__device__ __forceinline__ float bf_lo(unsigned w) { return (float)__builtin_bit_cast(h16x2, w)[0]; }
__device__ __forceinline__ float bf_hi(unsigned w) { return (float)__builtin_bit_cast(h16x2, w)[1]; }
__device__ __forceinline__ float sigmoidf_fast(float x) { return __builtin_amdgcn_rcpf(1.0f + __builtin_amdgcn_exp2f(-1.4426950408889634f * x)); }
__device__ __forceinline__ u32x4 pack8(const f32x4& v0, const f32x4& v1) { u32x4 w; w.x = cvt_pk_bf16(v0[0], v0[1]); w.y = cvt_pk_bf16(v0[2], v0[3]); w.z = cvt_pk_bf16(v1[0], v1[1]); w.w = cvt_pk_bf16(v1[2], v1[3]); return w; }

struct EpiIn {
    static constexpr bool PERM = true;
    bf16_t* seg0; size_t seg_stride; bf16_t* gates; bf16_t* kix; float* wix; float wscale;
    __device__ __forceinline__ bool keep(const Unit&) const { return false; }
    __device__ __forceinline__ void operator()(f32x4 (&acc)[2][2][4][2], const Unit& u, int wr, int wc, int fr, int fq) const {
        const int row0 = u.pm * BM + wr * 64 + fr;
        if (u.pn < 44) {
            const bool gate = u.pn >= 28;
            bf16_t* base = gate ? gates : seg0 + (size_t)(u.pn >> 2) * seg_stride;
            const int ld = gate ? 4096 : 1024;
            const int col0 = (gate ? (u.pn - 28) * BM : (u.pn & 3) * BM) + wc * 32 + 8 * fq;
#pragma unroll
            for (int ai = 0; ai < 2; ++ai)
#pragma unroll
                for (int m = 0; m < 4; ++m) { bf16_t* rowp = base + (size_t)(row0 + ai * HALF + m * 16) * ld + col0;
#pragma unroll
                    for (int bj = 0; bj < 2; ++bj) { f32x4 v0 = acc[ai][bj][m][0], v1 = acc[ai][bj][m][1];
                        if (gate) {
#pragma unroll
                            for (int e = 0; e < 4; ++e) { v0[e] = sigmoidf_fast(v0[e]); v1[e] = sigmoidf_fast(v1[e]); } }
                        *(u32x4*)(rowp + bj * HALF) = pack8(v0, v1); } }
        } else {
#pragma unroll
            for (int ai = 0; ai < 2; ++ai)
#pragma unroll
                for (int m = 0; m < 4; ++m) { const size_t row = (size_t)(row0 + ai * HALF + m * 16); const f32x4 v0 = acc[ai][0][m][0], v1 = acc[ai][0][m][1];
                    if (wc < 2) *(u32x4*)(kix + (row >> 5) * 2048 + ((wc * 4 + fq) * 32 + (row & 31)) * 8) = pack8(v0, v1);
                    else if (wc == 2 && fq < 2) { float* p = wix + row * 16 + 8 * fq; *(f32x4*)p = v0 * wscale; *(f32x4*)(p + 4) = v1 * wscale; } }
        }
    }
};

struct EpiMerged {
    static constexpr bool PERM = true;
    const bf16_t* gates; bf16_t* out;
    __device__ __forceinline__ bool keep(const Unit& u) const { return u.part == 0; }
    __device__ __forceinline__ void operator()(f32x4 (&acc)[2][2][4][2], const Unit& u, int wr, int wc, int fr, int fq) const {
        const int row0 = u.pm * BM + wr * 64 + fr, col0 = u.pn * BM + wc * 32 + 8 * fq;
#pragma unroll
        for (int ai = 0; ai < 2; ++ai)
#pragma unroll
            for (int m = 0; m < 4; ++m) { const size_t row = (size_t)(row0 + ai * HALF + m * 16);
#pragma unroll
                for (int bj = 0; bj < 2; ++bj) { const int col = col0 + bj * HALF;
                    const u32x4 gs = *(const u32x4*)(gates + row * 4096 + col), gd = *(const u32x4*)(gates + row * 4096 + 2048 + col);
                    float fs[8], fd[8];
#pragma unroll
                    for (int e = 0; e < 4; ++e) { fs[2 * e] = bf_lo(gs[e]); fs[2 * e + 1] = bf_hi(gs[e]); fd[2 * e] = fmaxf(bf_lo(gd[e]), 1e-20f); fd[2 * e + 1] = fmaxf(bf_hi(gd[e]), 1e-20f); }
                    f32x4 v0 = acc[ai][bj][m][0], v1 = acc[ai][bj][m][1];
                    if (u.part == 0) {
#pragma unroll
                        for (int e = 0; e < 4; ++e) { v0[e] *= fs[e] * __builtin_amdgcn_rcpf(fd[e]); v1[e] *= fs[4 + e] * __builtin_amdgcn_rcpf(fd[4 + e]); }
                        acc[ai][bj][m][0] = v0; acc[ai][bj][m][1] = v1;
                    } else {
#pragma unroll
                        for (int e = 0; e < 4; ++e) { v0[e] *= fd[e]; v1[e] *= fd[4 + e]; }
                        *(u32x4*)(out + row * 2048 + col) = pack8(v0, v1);
                    } } }
    }
};

struct EpiResid {
    static constexpr bool PERM = false;
    const float* base; float* out; const float* gt;
    int gstride;
    __device__ __forceinline__ bool keep(const Unit&) const { return false; }
    __device__ __forceinline__ void operator()(f32x4 (&acc)[2][2][4][2], const Unit& u, int wr, int wc, int fr, int fq) const {
        const int row0 = u.pm * BM + wr * 64 + fr, col0 = u.pn * BM + wc * 32 + 4 * fq;
        const float* g = gt + (size_t)(u.pm >> 5) * gstride;
#pragma unroll
        for (int bj = 0; bj < 2; ++bj)
#pragma unroll
            for (int n = 0; n < 2; ++n) { const int col = col0 + bj * HALF + n * 16; const f32x4 gv = *(const f32x4*)(g + col);
#pragma unroll
                for (int ai = 0; ai < 2; ++ai)
#pragma unroll
                    for (int m = 0; m < 4; ++m) { const size_t off = (size_t)(row0 + ai * HALF + m * 16) * 2048 + col;
                        const f32x4 bs = *(const f32x4*)(base + off); *(f32x4*)(out + off) = bs + gv * acc[ai][bj][m][n]; } }
    }
};

__device__ __forceinline__ float dpp_ror1(float v) { return __int_as_float(__builtin_amdgcn_update_dpp(0, __float_as_int(v), 0x121, 0xf, 0xf, false)); }
__device__ __forceinline__ float dpp_ror2(float v) { return __int_as_float(__builtin_amdgcn_update_dpp(0, __float_as_int(v), 0x122, 0xf, 0xf, false)); }
struct EpiGU {
    static constexpr bool PERM = true;
    bf16_t* act; float* ghalo; float* gdef; float* udef; const float* convw; const float* convb;
    __device__ __forceinline__ bool keep(const Unit&) const { return false; }
    __device__ __forceinline__ void operator()(f32x4 (&acc)[2][2][4][2], const Unit& u, int wr, int wc, int fr, int fq) const {
        constexpr int FF = 5632;
        const int f0 = u.pn * HALF + wc * 32 + 8 * fq;
        f32x4 w0[2], w1[2], w2[2], cb[2];
#pragma unroll
        for (int n = 0; n < 2; ++n) { w0[n] = *(const f32x4*)(convw + f0 + 4 * n); w1[n] = *(const f32x4*)(convw + FF + f0 + 4 * n); w2[n] = *(const f32x4*)(convw + 2 * FF + f0 + 4 * n); cb[n] = *(const f32x4*)(convb + f0 + 4 * n); }
#pragma unroll
        for (int ai = 0; ai < 2; ++ai) {
            const int rb = u.pm * BM + ai * HALF + wr * 64, blk = rb >> 6;
#pragma unroll
            for (int m = 0; m < 4; ++m) {
                f32x4 res[2];
#pragma unroll
                for (int n = 0; n < 2; ++n)
#pragma unroll
                    for (int e = 0; e < 4; ++e) {
                        const float g = acc[ai][0][m][n][e], gp = (m > 0) ? acc[ai][0][m - 1][n][e] : 0.f;
                        const float r1a = dpp_ror1(g), r1b = dpp_ror1(gp), r2a = dpp_ror2(g), r2b = dpp_ror2(gp);
                        const float g1 = (fr == 0) ? r1b : r1a, g2 = (fr < 2) ? r2b : r2a;
                        const float a = cb[n][e] + w0[n][e] * g2 + w1[n][e] * g1 + w2[n][e] * g;
                        res[n][e] = a * sigmoidf_fast(a) * acc[ai][1][m][n][e];
                    }
                const int row = rb + m * 16 + fr;
                if (m == 0 && fr < 2) {
                    float* gd = gdef + (size_t)(blk * 2 + fr) * FF + f0; float* ud = udef + (size_t)(blk * 2 + fr) * FF + f0;
                    *(f32x4*)gd = acc[ai][0][0][0]; *(f32x4*)(gd + 4) = acc[ai][0][0][1]; *(f32x4*)ud = acc[ai][1][0][0]; *(f32x4*)(ud + 4) = acc[ai][1][0][1];
                } else {
                    *(u32x4*)(act + (size_t)row * FF + f0) = pack8(res[0], res[1]);
                }
                if (m == 3 && fr >= 14) { float* gh = ghalo + (size_t)(blk * 2 + (fr - 14)) * FF + f0; *(f32x4*)gh = acc[ai][0][3][0]; *(f32x4*)(gh + 4) = acc[ai][0][3][1]; }
            }
        }
    }
};

template <class Epi, class Sched, bool ALIGN_EPI = false, bool SP2 = false>
__device__ __forceinline__ void gemm_phase(PG8_LAS unsigned char* lds, const Gemm g, const Sched& S, const Epi& E, const int tid) {
    const int wid = __builtin_amdgcn_readfirstlane(tid >> 6), lane = tid & 63, wr = wid >> 2, wc = wid & 3, fr = lane & 15, fq = lane >> 4;
    const int K = g.K, nt = K / BK;
    unsigned voffA[2], voffB[2];
#pragma unroll
    for (int i = 0; i < 2; ++i) { int R, C; stage_rc(tid * 16 + i * 8192, R, C); const int Rb = Epi::PERM ? ((R & ~31) + perm32(R & 31)) : R;
        voffA[i] = (unsigned)(R * K + C) * 2u; voffB[i] = (unsigned)(Rb * K + C) * 2u; }
    const size_t kstep = (size_t)(BK * 2);
    const size_t hstep = (size_t)HALF * K * 2;
    const size_t tstep = 2 * hstep;
    const unsigned ldsw = (unsigned)wid * 1024u;
    const int aoff = lds_byte(wr * 64 + fr, fq * 8), boff = lds_byte(wc * 32 + fr, fq * 8);
#define PG8_SA(b, h) (((b) * 2 + (h)) * HTB)
#define PG8_PA(u) ((const char*)((u).part ? g.A2 : g.A) + (size_t)(u).pm * tstep)
#define PG8_PB(u) ((const char*)((u).part ? g.Bt2 : g.Bt) + (size_t)(u).pn * tstep)
#define PG8_SB(b, h) ((4 + (b) * 2 + (h)) * HTB)
#define PG8_STAGE(bufoff, gbase, voff) do { _Pragma("unroll") for (int _i = 0; _i < 2; ++_i) \
        __builtin_amdgcn_global_load_lds((const unsigned*)((const char*)(gbase) + (voff)[_i]), (PG8_LAS unsigned*)(lds + (bufoff) + ldsw + _i * 8192), 16, 0, 0); } while (0)
#define PG8_LDA(dst, b, h) do { _Pragma("unroll") for (int m = 0; m < 4; ++m) _Pragma("unroll") for (int k = 0; k < 2; ++k) dst[m][k] = *(const PG8_LAS bf16x8*)(lds + PG8_SA(b, h) + aoff + m * 2048 + k * 1024); } while (0)
#define PG8_LDB(dst, b, h) do { _Pragma("unroll") for (int n = 0; n < 2; ++n) _Pragma("unroll") for (int k = 0; k < 2; ++k) dst[n][k] = *(const PG8_LAS bf16x8*)(lds + PG8_SB(b, h) + boff + n * 2048 + k * 1024); } while (0)
#define PG8_MMA(ai, bj, At, Bt) do { __builtin_amdgcn_s_setprio(1); _Pragma("unroll") for (int m = 0; m < 4; ++m) _Pragma("unroll") for (int n = 0; n < 2; ++n) _Pragma("unroll") for (int k = 0; k < 2; ++k) \
        acc[ai][bj][m][n] = __builtin_amdgcn_mfma_f32_16x16x32_f16(__builtin_bit_cast(h16x8, Bt[n][k]), __builtin_bit_cast(h16x8, At[m][k]), acc[ai][bj][m][n], 0, 0, 0); __builtin_amdgcn_s_setprio(0); } while (0)
#define PG8_WAIT_V(n) asm volatile("s_waitcnt vmcnt(" #n ")" ::: "memory")
#define PG8_WAIT_L(n) asm volatile("s_waitcnt lgkmcnt(" #n ")" ::: "memory")
#define PG8_BAR __builtin_amdgcn_s_barrier()
#define PG8_SCHED __builtin_amdgcn_sched_barrier(0)
    Unit cur, nxt; int ui = 0;
    if (!S.next(0, cur)) return;
    f32x4 acc[2][2][4][2];
#pragma unroll
    for (int a = 0; a < 2; ++a)
#pragma unroll
        for (int b = 0; b < 2; ++b)
#pragma unroll
            for (int m = 0; m < 4; ++m)
#pragma unroll
                for (int n = 0; n < 2; ++n) acc[a][b][m][n] = (f32x4){0.f, 0.f, 0.f, 0.f};
    bf16x8 At[4][2], B0[2][2], B1[2][2];
    const char* cA = PG8_PA(cur); const char* cB = PG8_PB(cur);
    if constexpr (SP2) {
        PG8_STAGE(PG8_SB(0, 0), cB, voffB); PG8_STAGE(PG8_SB(0, 1), cB + hstep, voffB); PG8_STAGE(PG8_SA(0, 0), cA, voffA); PG8_STAGE(PG8_SA(0, 1), cA + hstep, voffA);
        if (wr == 1) PG8_BAR;
        PG8_WAIT_V(2); PG8_BAR;
        PG8_STAGE(PG8_SB(1, 0), cB + kstep, voffB); PG8_STAGE(PG8_SA(1, 0), cA + kstep, voffA); PG8_STAGE(PG8_SB(1, 1), cB + hstep + kstep, voffB);
        PG8_WAIT_V(6); PG8_BAR;
    } else {
        PG8_STAGE(PG8_SB(0, 0), cB, voffB); PG8_STAGE(PG8_SA(0, 0), cA, voffA); PG8_STAGE(PG8_SB(0, 1), cB + hstep, voffB); PG8_STAGE(PG8_SA(0, 1), cA + hstep, voffA);
        if (wr == 1) PG8_BAR;
        PG8_WAIT_V(4); PG8_BAR;
        PG8_STAGE(PG8_SB(1, 0), cB + kstep, voffB); PG8_STAGE(PG8_SA(1, 0), cA + kstep, voffA); PG8_STAGE(PG8_SB(1, 1), cB + hstep + kstep, voffB);
        PG8_WAIT_V(6); PG8_BAR;
    }
    for (;;) {
        const bool has_next = S.next(ui + 1, nxt);
        const char* nA = has_next ? PG8_PA(nxt) : cA; const char* nB = has_next ? PG8_PB(nxt) : cB;
        for (int t = 0; t < nt; t += 2) {
            const bool last = (t == nt - 2);
            const char* a1 = cA + (size_t)(t + 1) * kstep;
            const char* a2 = last ? nA : cA + (size_t)(t + 2) * kstep; const char* b2 = last ? nB : cB + (size_t)(t + 2) * kstep;
            const char* a3 = a2 + kstep; const char* b3 = b2 + kstep;
            if constexpr (SP2) {
            PG8_LDB(B0, 0, 0); PG8_LDB(B1, 0, 1); PG8_SCHED; PG8_LDA(At, 0, 0); PG8_STAGE(PG8_SA(1, 1), a1 + hstep, voffA);
            PG8_WAIT_V(8); PG8_WAIT_L(0); PG8_BAR; PG8_MMA(0, 0, At, B0); PG8_MMA(0, 1, At, B1); PG8_BAR; PG8_SCHED;
            PG8_LDA(At, 0, 1); PG8_STAGE(PG8_SB(0, 0), b2, voffB); PG8_STAGE(PG8_SB(0, 1), b2 + hstep, voffB); PG8_STAGE(PG8_SA(0, 0), a2, voffA);
            PG8_WAIT_V(8); PG8_WAIT_L(0); PG8_BAR; PG8_MMA(1, 0, At, B0); PG8_MMA(1, 1, At, B1); PG8_BAR; PG8_SCHED;
            PG8_LDB(B0, 1, 0); PG8_LDB(B1, 1, 1); PG8_SCHED; PG8_LDA(At, 1, 0); PG8_STAGE(PG8_SA(0, 1), a2 + hstep, voffA);
            PG8_WAIT_V(8); PG8_WAIT_L(0); PG8_BAR; PG8_MMA(0, 0, At, B0); PG8_MMA(0, 1, At, B1); PG8_BAR; PG8_SCHED;
            PG8_LDA(At, 1, 1); PG8_STAGE(PG8_SB(1, 0), b3, voffB); PG8_STAGE(PG8_SB(1, 1), b3 + hstep, voffB); PG8_STAGE(PG8_SA(1, 0), a3, voffA);
            PG8_WAIT_V(8); PG8_WAIT_L(0); PG8_BAR; PG8_MMA(1, 0, At, B0); PG8_MMA(1, 1, At, B1); PG8_BAR; PG8_SCHED;
            } else {
            PG8_LDB(B0, 0, 0); PG8_SCHED; PG8_LDA(At, 0, 0); PG8_STAGE(PG8_SA(1, 1), a1 + hstep, voffA);
            PG8_WAIT_L(8); PG8_BAR; PG8_WAIT_L(0); PG8_MMA(0, 0, At, B0); PG8_BAR; PG8_SCHED;
            PG8_LDB(B1, 0, 1); PG8_STAGE(PG8_SB(0, 0), b2, voffB);
            PG8_BAR; PG8_WAIT_L(0); PG8_MMA(0, 1, At, B1); PG8_BAR;
            PG8_LDA(At, 0, 1); PG8_STAGE(PG8_SA(0, 0), a2, voffA);
            PG8_BAR; PG8_WAIT_L(0); PG8_MMA(1, 0, At, B0); PG8_BAR; PG8_SCHED;
            PG8_STAGE(PG8_SB(0, 1), b2 + hstep, voffB);
            PG8_WAIT_V(6); PG8_BAR; PG8_MMA(1, 1, At, B1); PG8_BAR;
            PG8_LDB(B0, 1, 0); PG8_SCHED; PG8_LDA(At, 1, 0); PG8_STAGE(PG8_SA(0, 1), a2 + hstep, voffA);
            PG8_WAIT_L(8); PG8_BAR; PG8_WAIT_L(0); PG8_MMA(0, 0, At, B0); PG8_BAR; PG8_SCHED;
            PG8_LDB(B1, 1, 1); PG8_STAGE(PG8_SB(1, 0), b3, voffB);
            PG8_BAR; PG8_WAIT_L(0); PG8_MMA(0, 1, At, B1); PG8_BAR;
            PG8_LDA(At, 1, 1); PG8_STAGE(PG8_SA(1, 0), a3, voffA);
            PG8_BAR; PG8_WAIT_L(0); PG8_MMA(1, 0, At, B0); PG8_BAR; PG8_SCHED;
            PG8_STAGE(PG8_SB(1, 1), b3 + hstep, voffB);
            PG8_WAIT_V(6); PG8_BAR; PG8_MMA(1, 1, At, B1); PG8_BAR;
            }
        }
        if constexpr (ALIGN_EPI) { if (wr == 0) PG8_BAR; }
        E(acc, cur, wr, wc, fr, fq);
        if (!has_next) break;
        if (!E.keep(cur))
#pragma unroll
        for (int a = 0; a < 2; ++a)
#pragma unroll
            for (int b = 0; b < 2; ++b)
#pragma unroll
                for (int m = 0; m < 4; ++m)
#pragma unroll
                    for (int n = 0; n < 2; ++n) acc[a][b][m][n] = (f32x4){0.f, 0.f, 0.f, 0.f};
        cur = nxt; cA = nA; cB = nB; ++ui;
        if constexpr (ALIGN_EPI) { if (wr == 1) PG8_BAR; }
    }
    PG8_WAIT_V(0);
    if constexpr (!ALIGN_EPI) { if (wr == 0) PG8_BAR; }
    PG8_BAR;
#undef PG8_SA
#undef PG8_PA
#undef PG8_PB
#undef PG8_SB
#undef PG8_STAGE
#undef PG8_LDA
#undef PG8_LDB
#undef PG8_MMA
#undef PG8_WAIT_V
#undef PG8_WAIT_L
#undef PG8_BAR
#undef PG8_SCHED
}
}


constexpr int BATCH = 2, SEQ = 8192, DM = 2048, MROWS = BATCH * SEQ;
constexpr int HD = 128, NHEAD = 8, WATT = NHEAD * HD;
constexpr int NIH = 16, IDIM = 64, TOPK = 256;
constexpr int FF = 5632, P_IN = 11344, N_IN_PAD = 11520;
constexpr float EPS = 1e-6f, LOG2E = 1.4426950408889634f;
constexpr float QK_SCALE = 0.08838834764831845f;
constexpr int NPH = 12;
constexpr int N_LAUNCHES = MK_N_LAUNCHES;
constexpr int NWAVES = 8;

constexpr size_t MiB = 1u << 20;
constexpr size_t WS_CTL = 0, WS_BM = 1 * MiB, ZERO_BYTES = 17 * MiB;
constexpr size_t WS_MOD = 17 * MiB;
constexpr size_t WS_WIN = 18 * MiB;
constexpr size_t WS_WOSB = 63 * MiB, WS_WODS = 67 * MiB, WS_WOUT = 71 * MiB;
constexpr size_t WS_WGU = 79 * MiB;
constexpr size_t WS_WDN = 123 * MiB;
constexpr size_t WS_H = 145 * MiB;
constexpr size_t WS_SEG = 209 * MiB, SEG_BYTES = 32 * MiB;
constexpr size_t WS_KIX = 433 * MiB, WS_WIX = 435 * MiB, WS_END = 436 * MiB;
constexpr size_t WS_ACT = WS_SEG;
constexpr size_t HALO_BYTES = (size_t)512 * FF * 4;
constexpr size_t WS_GHALO = WS_WIN, WS_GDEF = WS_WIN + 12 * MiB, WS_UDEF = WS_WIN + 24 * MiB;
static_assert(WS_WIN + (size_t)N_IN_PAD * DM * 2 <= WS_WOSB && WS_WGU + (size_t)2 * FF * DM * 2 <= WS_WDN && WS_WDN + (size_t)DM * FF * 2 <= WS_H && WS_H + (size_t)MROWS * DM * 2 <= WS_SEG, "ws map");
static_assert(WS_SEG + 7 * SEG_BYTES <= WS_KIX && WS_ACT + (size_t)MROWS * FF * 2 <= WS_KIX && HALO_BYTES <= 12 * MiB && WS_UDEF + HALO_BYTES <= WS_WOSB, "ws map 2");
constexpr int CW_BAR = 4096;

constexpr int RING_OFF = 0, RING_BYTES = 131072;
constexpr int LDSCTL_OFF = RING_BYTES, MISC_OFF = LDSCTL_OFF + 320;
constexpr int EXTRA_OFF = 131584;
constexpr int LDS_BYTES = 147456;

#define GAS __attribute__((address_space(1)))
#define LAS __attribute__((address_space(3)))
typedef unsigned short bf16;
typedef float f32x4 __attribute__((ext_vector_type(4)));
typedef float f32x16 __attribute__((ext_vector_type(16)));
typedef short bf16x8 __attribute__((ext_vector_type(8)));
typedef short s16x4 __attribute__((ext_vector_type(4)));
typedef unsigned u32x4 __attribute__((ext_vector_type(4)));
typedef unsigned u32x2 __attribute__((ext_vector_type(2)));
typedef unsigned short u16x2 __attribute__((ext_vector_type(2)));
typedef unsigned long long u64;
typedef GAS unsigned gu32;
#define LDS_WAIT() asm volatile("s_waitcnt lgkmcnt(0)" ::: "memory")
#define VM_WAIT() asm volatile("s_waitcnt vmcnt(0)" ::: "memory")
#define SBAR() __builtin_amdgcn_sched_barrier(0)
#define XB_TMO      128
#define XB_XCNT(j)  (256  + 64 * (j))
#define XB_XSUB(j)  (1280 + 64 * (j))
#define XB_XGEN(j)  (2304 + 64 * (j))
#define XB_TOP      3328
#define XB_TOPGEN   3392
#define XCD_BAR_WORDS 3456
#define XB_SPIN_CAP (1u << 18)

__device__ __forceinline__ unsigned xb_ld(unsigned* p)              { return __hip_atomic_load(p, __ATOMIC_RELAXED, __HIP_MEMORY_SCOPE_AGENT); }
__device__ __forceinline__ unsigned xb_add(unsigned* p, unsigned v) { return __hip_atomic_fetch_add(p, v, __ATOMIC_RELAXED, __HIP_MEMORY_SCOPE_AGENT); }
__device__ __forceinline__ unsigned xb_xcc_id() { return (unsigned)__builtin_amdgcn_s_getreg((3 << 11) | 20) & 0xFu; }
#define XB_SPIN(cond, bar) do { unsigned _sp = 0; while (cond) { __builtin_amdgcn_s_sleep(1); \
    if ((++_sp & 255u) == 0u) { if (xb_ld(&(bar)[XB_TMO])) break; if (_sp > XB_SPIN_CAP) { atomicAdd(&(bar)[XB_TMO], 1u); break; } } } } while (0)

struct XcdBarrier {
    unsigned* bar; unsigned x;
    volatile LAS unsigned* st;
};

__device__ __forceinline__ XcdBarrier xcd_barrier_post(unsigned* bar, volatile LAS unsigned* st, const bool thread0  ) {
    XcdBarrier b; b.bar = bar; b.x = xb_xcc_id(); b.st = st;
    if (thread0) (void)xb_add(&bar[XB_XCNT(b.x)], 1u);
    return b;
}
__device__ __forceinline__ void xcd_barrier_complete(unsigned* bar, unsigned x, unsigned& nloc, unsigned& nx) {
    const unsigned G = gridDim.x * gridDim.y * gridDim.z;
    unsigned sum, cnt, mine, sp = 0u;
    for (;;) {
        sum = 0u; cnt = 0u; mine = 0u;
#pragma unroll
        for (unsigned j = 0; j < 16; ++j) { const unsigned c = xb_ld(&bar[XB_XCNT(j)]); sum += c; cnt += (c > 0u) ? 1u : 0u; mine = (j == x) ? c : mine; }
        if (sum == G) break;
        __builtin_amdgcn_s_sleep(1);
        if ((++sp & 255u) == 0u) { if (xb_ld(&bar[XB_TMO])) break; if (sp > XB_SPIN_CAP) { atomicAdd(&bar[XB_TMO], 1u); break; } }
    }
    nloc = mine > 0u ? mine : 1u; nx = cnt > 0u ? cnt : 1u;
}

__device__ __forceinline__ void xcd_barrier(const XcdBarrier& b, const bool thread0  ) {
    asm volatile("s_waitcnt vmcnt(0)" ::: "memory");
    __syncthreads();
    if (thread0) {
        unsigned* bar = b.bar;
        __builtin_amdgcn_s_waitcnt(0);
        unsigned nloc = b.st[0], nx = b.st[1];
        if (nloc == 0u) { xcd_barrier_complete(bar, b.x, nloc, nx); b.st[0] = nloc; b.st[1] = nx; }
        const unsigned old = xb_add(&bar[XB_XSUB(b.x)], 1u);
        const unsigned gen = old / nloc;
        if (old + 1u == (gen + 1u) * nloc) {
            __builtin_amdgcn_fence(__ATOMIC_RELEASE, "agent");
            asm volatile("s_waitcnt vmcnt(0)" ::: "memory");
            const unsigned og = xb_add(&bar[XB_TOP], 1u);
            const unsigned tg = og / nx;
            if (og + 1u == (tg + 1u) * nx) xb_add(&bar[XB_TOPGEN], 1u);
            else XB_SPIN(xb_ld(&bar[XB_TOPGEN]) == tg, bar);
            __builtin_amdgcn_fence(__ATOMIC_ACQUIRE, "agent");
            xb_add(&bar[XB_XGEN(b.x)], 1u);
            asm volatile("s_waitcnt vmcnt(0)" ::: "memory");
        } else {
            XB_SPIN(xb_ld(&bar[XB_XGEN(b.x)]) == gen, bar);
            __builtin_amdgcn_fence(__ATOMIC_ACQUIRE, "agent");
            asm volatile("s_waitcnt vmcnt(0)" ::: "memory");
        }
    }
    __syncthreads();
}

struct Frame {
    LAS unsigned char* lds;
    volatile LAS unsigned* MISC;
    int tid, lane, wave;
    int vcu, G;
};
__device__ __forceinline__ float wave_sum(float v) {
#pragma unroll
    for (int o = 1; o < 64; o <<= 1) v += __shfl_xor(v, o);
    return v;
}
__device__ __forceinline__ int wave_sum_i(int v) {
#pragma unroll
    for (int o = 1; o < 64; o <<= 1) v += __shfl_xor(v, o);
    return v;
}
__device__ __forceinline__ unsigned pk2(float lo, float hi) { return pg8::cvt_pk_bf16(lo, hi); }
__device__ __forceinline__ unsigned cvtpk(float lo, float hi) { return pg8::cvt_pk_bf16(lo, hi); }


__device__ __forceinline__ f32x16 MFMA32(bf16x8 a, bf16x8 b, f32x16 c) { return __builtin_amdgcn_mfma_f32_32x32x16_f16(__builtin_bit_cast(pg8::h16x8, a), __builtin_bit_cast(pg8::h16x8, b), c, 0, 0, 0); }
__device__ __forceinline__ void ph0_mod(const Frame& F, const float* c, const float* w_ada, const float* b_ada, float* mod) {
    LAS float* sc = (LAS float*)(F.lds);
    LAS float* part = (LAS float*)(F.lds + 16384);
    for (int i = F.tid; i < 2 * DM; i += NWAVES * 64) { const float v = c[i]; sc[i] = v / (1.f + __expf(-v)); }
    __syncthreads();
    for (int cg = F.vcu; cg < 256; cg += F.G) {
        const int c4 = F.tid % 12, dr = F.tid / 12;
        if (dr < 42) {
            f32x4 a0 = {0.f, 0.f, 0.f, 0.f}, a1 = {0.f, 0.f, 0.f, 0.f};
            const float* wp = w_ada + (size_t)48 * cg + 4 * c4;
#pragma unroll 8
            for (int d = dr; d < DM; d += 42) { const f32x4 w = *(const f32x4*)(wp + (size_t)d * (6 * DM)); a0 += sc[d] * w; a1 += sc[DM + d] * w; }
#pragma unroll
            for (int e = 0; e < 4; ++e) { part[dr * 96 + 4 * c4 + e] = a0[e]; part[dr * 96 + 48 + 4 * c4 + e] = a1[e]; }
        }
        __syncthreads();
        if (F.tid < 96) { float s = 0.f; for (int r = 0; r < 42; ++r) s += part[r * 96 + F.tid]; const int b = F.tid / 48, col = F.tid % 48; mod[b * (6 * DM) + 48 * cg + col] = s + b_ada[48 * cg + col]; }
        __syncthreads();
    }
}
template <int MODE> __device__ __forceinline__ int row_map(int n, int off) {
    if (MODE == 0) return off + n;
    if (MODE == 1) return n < 7168 ? n : (n < 7248 ? 11264 + (n - 7168) : 7168 + (n - 7248));
    if (MODE == 2) return (n >> 7) * 256 + (n & 127);
    return (n >> 7) * 256 + 128 + (n & 127);
}
template <int MODE> __device__ __forceinline__ void tr_item(const float* W, int K, int N, bf16* WT, int off, LAS float* scr, int item, int lane) {
    const int nblk = (N + 31) / 32, kb = item / nblk, nb = item % nblk, k0 = 64 * kb, n0 = 32 * nb;
    const bool cok = (n0 + (lane & 31)) < N;
#pragma unroll 8
    for (int i = 0; i < 32; ++i) { const int kk = 2 * i + (lane >> 5); scr[kk * 33 + (lane & 31)] = cok ? W[(size_t)(k0 + kk) * N + n0 + (lane & 31)] : 0.f; }
    LDS_WAIT(); asm volatile("" ::: "memory");
    const int c = lane & 7;
#pragma unroll
    for (int j = 0; j < 4; ++j) { const int n = (lane >> 3) + 8 * j; const LAS float* s = scr + (8 * c) * 33 + n;
        u32x4 o; o.x = pk2(s[0 * 33], s[1 * 33]); o.y = pk2(s[2 * 33], s[3 * 33]); o.z = pk2(s[4 * 33], s[5 * 33]); o.w = pk2(s[6 * 33], s[7 * 33]);
        if (n0 + n < N) *(GAS u32x4*)(WT + (size_t)row_map<MODE>(n0 + n, off) * K + k0 + 8 * c) = o; }
    LDS_WAIT(); asm volatile("" ::: "memory");
}
struct WPtrs { const float *w_in, *w_osb, *w_ods, *w_out, *w_gate, *w_up, *w_down; bf16 *t_in, *t_osb, *t_ods, *t_out, *t_gu, *t_dn; };
__device__ __forceinline__ void ph0_weights(const Frame& F, const WPtrs& P) {
    LAS float* scr = (LAS float*)(F.lds + RING_OFF + F.wave * 16384);
    const int gw = F.vcu * NWAVES + F.wave, NGW = F.G * NWAVES;
    constexpr int I_IN = (DM / 64) * ((P_IN + 31) / 32), I_O = (WATT / 64) * (DM / 32), I_OUT = (DM / 64) * (DM / 32), I_G = (DM / 64) * (FF / 32), I_D = (FF / 64) * (DM / 32);
    constexpr int NITEMS = I_IN + 2 * I_O + I_OUT + 2 * I_G + I_D;
    for (int it = gw; it < NITEMS; it += NGW) {
        int r = it;
        if (r < I_IN) { tr_item<1>(P.w_in, DM, P_IN, P.t_in, 0, scr, r, F.lane); continue; } r -= I_IN;
        if (r < I_O) { tr_item<0>(P.w_osb, WATT, DM, P.t_osb, 0, scr, r, F.lane); continue; } r -= I_O;
        if (r < I_O) { tr_item<0>(P.w_ods, WATT, DM, P.t_ods, 0, scr, r, F.lane); continue; } r -= I_O;
        if (r < I_OUT) { tr_item<0>(P.w_out, DM, DM, P.t_out, 0, scr, r, F.lane); continue; } r -= I_OUT;
        if (r < I_G) { tr_item<2>(P.w_gate, DM, FF, P.t_gu, 0, scr, r, F.lane); continue; } r -= I_G;
        if (r < I_G) { tr_item<3>(P.w_up, DM, FF, P.t_gu, 0, scr, r, F.lane); continue; } r -= I_G;
        tr_item<0>(P.w_down, FF, DM, P.t_dn, 0, scr, r, F.lane);
    }
    { GAS u32x4* z = (GAS u32x4*)(P.t_in + (size_t)P_IN * DM); const int n16 = (N_IN_PAD - P_IN) * DM * 2 / 16;
      for (int i = F.vcu * (NWAVES * 64) + F.tid; i < n16; i += F.G * NWAVES * 64) z[i] = (u32x4){0u, 0u, 0u, 0u}; }
}

__device__ __forceinline__ void norm_mod_rows(const Frame& F, const float* X, bf16* H, const float* g, const float* shift, const float* scale) {
    const int gw = F.vcu * NWAVES + F.wave, NGW = F.G * NWAVES;
    for (int rb = gw; rb < MROWS / 8; rb += NGW) {
        const int b = (rb * 8) / SEQ;
        f32x4 gs[8], sh[8];
#pragma unroll
        for (int j = 0; j < 8; ++j) { const int col = 4 * (64 * j + F.lane); gs[j] = *(const f32x4*)(g + col) * (1.0f + *(const f32x4*)(scale + (size_t)b * 6 * DM + col)); sh[j] = *(const f32x4*)(shift + (size_t)b * 6 * DM + col); }
        for (int rr = 0; rr < 8; ++rr) {
            const size_t row = (size_t)rb * 8 + rr;
            const GAS f32x4* xr = (const GAS f32x4*)(X + row * DM) + F.lane;
            f32x4 v[8]; float s = 0.f;
#pragma unroll
            for (int j = 0; j < 8; ++j) { v[j] = xr[64 * j]; s += (v[j].x * v[j].x + v[j].y * v[j].y) + (v[j].z * v[j].z + v[j].w * v[j].w); }
            const float rs = 1.0f / sqrtf(wave_sum(s) * (1.0f / DM) + EPS);
            GAS u32x2* o8 = (GAS u32x2*)(H + row * DM) + F.lane;
#pragma unroll
            for (int j = 0; j < 8; ++j) { const f32x4 y = v[j] * rs * gs[j] + sh[j]; u32x2 w; w.x = cvtpk(y.x, y.y); w.y = cvtpk(y.z, y.w); o8[64 * j] = w; }
        }
    }
}
__device__ __forceinline__ void norm_final_rows(const Frame& F, float* X, const float* g) {
    const int gw = F.vcu * NWAVES + F.wave, NGW = F.G * NWAVES;
    f32x4 gs[8];
#pragma unroll
    for (int j = 0; j < 8; ++j) gs[j] = *(const f32x4*)(g + 4 * (64 * j + F.lane));
    for (int row = gw; row < MROWS; row += NGW) {
        GAS f32x4* xr = (GAS f32x4*)(X + (size_t)row * DM) + F.lane;
        f32x4 v[8]; float s = 0.f;
#pragma unroll
        for (int j = 0; j < 8; ++j) { v[j] = xr[64 * j]; s += (v[j].x * v[j].x + v[j].y * v[j].y) + (v[j].z * v[j].z + v[j].w * v[j].w); }
        const float rs = 1.0f / sqrtf(wave_sum(s) * (1.0f / DM) + EPS);
#pragma unroll
        for (int j = 0; j < 8; ++j) xr[64 * j] = v[j] * rs * gs[j];
    }
}

namespace att {
constexpr int PITCH = WATT;
constexpr int SHM_T = 16384;
constexpr int OFF_V = 0, OFF_K = 2 * SHM_T, OFF_WS = 4 * SHM_T, OFF_TAB = OFF_WS + 2048, OFF_FLAG = OFF_TAB + 512;
#define KSWZ(row, colB) ((row) * 256 + ((colB) ^ (((row) & 7) << 4)))
__device__ __forceinline__ int v_st(int k, int c) { const int kk = (k & ~0xC) | ((k & 4) << 1) | ((k & 8) >> 1); return ((kk >> 3) * 4 + (c >> 5)) * 512 + ((kk & 7) * 32 + (c & 31)) * 2; }
__device__ __forceinline__ int v_rd_base(int lane) { return ((lane & 3) << 3) | (((lane >> 2) & 3) << 6) | (((lane >> 4) & 1) << 5) | (((lane >> 5) & 1) << 8); }
constexpr int v_rd_off(int d0, int ks, int half) { return d0 * 512 + ks * 4096 + half * 2048; }
__device__ __forceinline__ int crow(int r, int hi) { return (r & 3) + 8 * (r >> 2) + 4 * hi; }

__device__ __forceinline__ void qkt(f32x16& p0, f32x16& p1, const LAS char* Kb, int r32, int hi, const bf16x8* qr) {
    p0 = f32x16{}; p1 = f32x16{};
    const LAS char* kb[4];
#pragma unroll
    for (int dd = 0; dd < 4; ++dd) kb[dd] = Kb + KSWZ(r32, (dd * 16 + hi * 8) * 2);
#pragma unroll
    for (int d0 = 0; d0 < 8; ++d0) { const LAS char* a = kb[d0 & 3] + (d0 >> 2) * 128;
        const bf16x8 b0 = *(const LAS bf16x8*)a;
        const bf16x8 b1 = *(const LAS bf16x8*)(a + 32 * 256);
        p0 = MFMA32(b0, qr[d0], p0);
        p1 = MFMA32(b1, qr[d0], p1); }
}
__device__ __forceinline__ void pv_tile(f32x16* o, int vb0, bf16x8 pa0, bf16x8 pa1, bf16x8 pa2, bf16x8 pa3) {
#define TRRD(dst, off) asm volatile("ds_read_b64_tr_b16 %0, %1 offset:%2" : "=&v"(dst) : "v"(vb0), "i"(off) : "memory")
#define PV_D0(d0) do { s16x4 l0, l1, l2, l3, h0, h1, h2, h3; constexpr int b_ = v_rd_off(d0, 0, 0); \
        TRRD(l0, b_); TRRD(h0, b_ + 2048); TRRD(l1, b_ + 4096); TRRD(h1, b_ + 6144); TRRD(l2, b_ + 8192); TRRD(h2, b_ + 10240); TRRD(l3, b_ + 12288); TRRD(h3, b_ + 14336); \
        asm volatile("s_waitcnt lgkmcnt(0)" ::: "memory"); SBAR(); \
        o[d0] = MFMA32(pa0, (bf16x8){l0[0], l0[1], l0[2], l0[3], h0[0], h0[1], h0[2], h0[3]}, o[d0]);   \
        o[d0] = MFMA32(pa1, (bf16x8){l1[0], l1[1], l1[2], l1[3], h1[0], h1[1], h1[2], h1[3]}, o[d0]);   \
        o[d0] = MFMA32(pa2, (bf16x8){l2[0], l2[1], l2[2], l2[3], h2[0], h2[1], h2[2], h2[3]}, o[d0]);   \
        o[d0] = MFMA32(pa3, (bf16x8){l3[0], l3[1], l3[2], l3[3], h3[0], h3[1], h3[2], h3[3]}, o[d0]); } while (0)
    PV_D0(0); PV_D0(1); PV_D0(2); PV_D0(3);
#undef PV_D0
#undef TRRD
}
template <int HALF> __device__ __forceinline__ void qkt_half(f32x16& p, const LAS char* Kb, int r32, int hi, const bf16x8* qr) {
    p = f32x16{};
    const LAS char* kb[4];
#pragma unroll
    for (int dd = 0; dd < 4; ++dd) kb[dd] = Kb + KSWZ(r32, (dd * 16 + hi * 8) * 2);
#pragma unroll
    for (int d0 = 0; d0 < 8; ++d0) { const LAS char* a = kb[d0 & 3] + (d0 >> 2) * 128 + HALF * 32 * 256;
        p = MFMA32(*(const LAS bf16x8*)a, qr[d0], p); }
}
template <int HALF> __device__ __forceinline__ void pv_half(f32x16* o, int vb0, bf16x8 pa0, bf16x8 pa1) {
#define TRRD(dst, off) asm volatile("ds_read_b64_tr_b16 %0, %1 offset:%2" : "=&v"(dst) : "v"(vb0), "i"(off) : "memory")
#define PV_D0(d0) do { s16x4 l0, l1, h0, h1; constexpr int b_ = v_rd_off(d0, 2 * HALF, 0); \
        TRRD(l0, b_); TRRD(h0, b_ + 2048); TRRD(l1, b_ + 4096); TRRD(h1, b_ + 6144); \
        asm volatile("s_waitcnt lgkmcnt(0)" ::: "memory"); SBAR(); \
        o[d0] = MFMA32(pa0, (bf16x8){l0[0], l0[1], l0[2], l0[3], h0[0], h0[1], h0[2], h0[3]}, o[d0]);   \
        o[d0] = MFMA32(pa1, (bf16x8){l1[0], l1[1], l1[2], l1[3], h1[0], h1[1], h1[2], h1[3]}, o[d0]); } while (0)
    PV_D0(0); PV_D0(1); PV_D0(2); PV_D0(3);
#undef PV_D0
#undef TRRD
}
__device__ __forceinline__ void pack_half(const f32x16& p, bf16x8& pa0, bf16x8& pa1) {
#define PK4(P, B_, OUT) do { unsigned a0 = cvtpk(P[B_+0], P[B_+1]), a1 = cvtpk(P[B_+2], P[B_+3]);                          \
        unsigned b0 = cvtpk(P[B_+4], P[B_+5]), b1 = cvtpk(P[B_+6], P[B_+7]);                                             \
        auto r0 = __builtin_amdgcn_permlane32_swap(a0, b0, false, false); auto r1 = __builtin_amdgcn_permlane32_swap(a1, b1, false, false); \
        u32x4 w = {r0[0], r1[0], r0[1], r1[1]}; OUT = *reinterpret_cast<bf16x8*>(&w); } while (0)
    PK4(p, 0, pa0); PK4(p, 8, pa1);
#undef PK4
}
__device__ __forceinline__ void pack_p(const f32x16& p0, const f32x16& p1, bf16x8& pa0, bf16x8& pa1, bf16x8& pa2, bf16x8& pa3) {
#define PK4(P, B_, OUT) do { unsigned a0 = cvtpk(P[B_+0], P[B_+1]), a1 = cvtpk(P[B_+2], P[B_+3]);                          \
        unsigned b0 = cvtpk(P[B_+4], P[B_+5]), b1 = cvtpk(P[B_+6], P[B_+7]);                                             \
        auto r0 = __builtin_amdgcn_permlane32_swap(a0, b0, false, false); auto r1 = __builtin_amdgcn_permlane32_swap(a1, b1, false, false); \
        u32x4 w = {r0[0], r1[0], r0[1], r1[1]}; OUT = *reinterpret_cast<bf16x8*>(&w); } while (0)
    PK4(p0, 0, pa0); PK4(p0, 8, pa1); PK4(p1, 0, pa2); PK4(p1, 8, pa3);
#undef PK4
}
__device__ __forceinline__ float swap_other(float own, int hi) {
    auto rr = __builtin_amdgcn_permlane32_swap(__float_as_uint(own), __float_as_uint(own), false, false);
    return hi ? __uint_as_float(rr[0]) : __uint_as_float(rr[1]);
}
struct Stage { bf16x8 k0, k1, v0, v1; };
__device__ __forceinline__ void stage_load(Stage& S, const bf16* Kp, const bf16* Vp, int key0, int sr, int sc) {
    const bf16* kp = Kp + (size_t)(key0 + sr) * PITCH + sc; const bf16* vp = Vp + (size_t)(key0 + sr) * PITCH + sc;
    S.k0 = *(const bf16x8*)kp; S.k1 = *(const bf16x8*)(kp + 32 * PITCH); S.v0 = *(const bf16x8*)vp; S.v1 = *(const bf16x8*)(vp + 32 * PITCH);
}
__device__ __forceinline__ void stage_write(const Stage& S, LAS char* Kl, LAS char* Vl, int kws, int vst0, int vst1) {
    *(LAS bf16x8*)(Kl + kws) = S.k0; *(LAS bf16x8*)(Kl + kws + 32 * 256) = S.k1; *(LAS bf16x8*)(Vl + vst0) = S.v0; *(LAS bf16x8*)(Vl + vst1) = S.v1;
}
__device__ __forceinline__ void store_o(const f32x16* o, const float* rscale  , bf16* Ow, int r32, int hi) {
    int lo = 4 * hi * PITCH + r32; asm volatile("" : "+v"(lo));
#pragma unroll
    for (int r = 0; r < 16; ++r) { const int orow = (r & 3) + 8 * (r >> 2);
#pragma unroll
        for (int d0 = 0; d0 < 4; ++d0) { const float v = rscale ? o[d0][r] * rscale[r] : o[d0][r]; const float vn = __shfl_xor(v, 1);
            if ((r32 & 1) == 0) *(unsigned*)(Ow + (size_t)(lo + orow * PITCH + d0 * 32)) = cvtpk(v, vn); } }
}

__device__ __forceinline__ void sb_math(f32x16& p0, f32x16& p1, float& R, int dq, bool need_mask, int hi) {
    constexpr float C2 = QK_SCALE * LOG2E;
    f32x16 k0, k1;
#pragma unroll
    for (int r = 0; r < 16; ++r) {
        const int c = (r & 3) + 8 * (r >> 2);
        { const float x = p0[r] * C2, t = __builtin_amdgcn_exp2f(-fabsf(x)), rr = __builtin_amdgcn_rcpf(1.0f + t), tr = t * rr; const bool pos = x >= 0.f;
          float be = pos ? rr : tr, ke = pos ? tr : rr; if (need_mask && !(c < dq)) { be = 0.f; ke = 1.f; } p0[r] = be; k0[r] = ke; }
        { const float x = p1[r] * C2, t = __builtin_amdgcn_exp2f(-fabsf(x)), rr = __builtin_amdgcn_rcpf(1.0f + t), tr = t * rr; const bool pos = x >= 0.f;
          float be = pos ? rr : tr, ke = pos ? tr : rr; if (need_mask && !(c + 32 < dq)) { be = 0.f; ke = 1.f; } p1[r] = be; k1[r] = ke; }
    }
    float L[9]; L[0] = 1.0f;
#pragma unroll
    for (int j = 0; j < 8; ++j) { const int g = 3 - (j & 3); const f32x16& kk = (j < 4) ? k1 : k0; L[j + 1] = L[j] * ((kk[4 * g] * kk[4 * g + 1]) * (kk[4 * g + 2] * kk[4 * g + 3])); }
#pragma unroll
    for (int j = 0; j < 8; ++j) {
        auto rr = __builtin_amdgcn_permlane32_swap(__float_as_uint(L[j + 1]), __float_as_uint(L[j]), false, false);
        const float foreign = hi ? __uint_as_float(rr[0]) : __uint_as_float(rr[1]);
        float P = R * (L[j] * foreign);
        const int g = 3 - (j & 3);
        if (j < 4) { p1[4 * g + 3] *= P; P *= k1[4 * g + 3]; p1[4 * g + 2] *= P; P *= k1[4 * g + 2]; p1[4 * g + 1] *= P; P *= k1[4 * g + 1]; p1[4 * g] *= P; }
        else       { p0[4 * g + 3] *= P; P *= k0[4 * g + 3]; p0[4 * g + 2] *= P; P *= k0[4 * g + 2]; p0[4 * g + 1] *= P; P *= k0[4 * g + 1]; p0[4 * g] *= P; }
    }
    R = R * (L[8] * swap_other(L[8], hi));
}
__device__ __forceinline__ void sb_block(const Frame& F, int b, int h, int qb, const bf16* Qb, const bf16* Kb, const bf16* Vb, bf16* Ob) {
    LAS char* lds = (LAS char*)F.lds;
    const int tid = F.tid, wid = F.wave, lane = F.lane, r32 = lane & 31, hi = lane >> 5;
    const int t0 = qb * 256, tq = t0 + wid * 32 + r32;
    const size_t rowbase = (size_t)b * SEQ;
    const bf16* Qp = Qb + (rowbase + t0) * PITCH + h * HD; bf16* Op = Ob + (rowbase + t0) * PITCH + h * HD;
    const bf16* Kp = Kb + rowbase * PITCH + h * HD; const bf16* Vp = Vb + rowbase * PITCH + h * HD;
    bf16x8 qr[8];
#pragma unroll
    for (int d0 = 0; d0 < 8; ++d0) qr[d0] = *(const bf16x8*)(Qp + (size_t)(wid * 32 + r32) * PITCH + d0 * 16 + hi * 8);
    const int sr = tid >> 4, sc = (tid & 15) * 8, kws = KSWZ(sr, sc * 2), vst0 = v_st(sr, sc), vst1 = vst0 + 8192  ;
    LAS char* Vl = lds + OFF_V; LAS char* Kl = lds + OFF_K;
    LAS unsigned* flags = (LAS unsigned*)(lds + OFF_FLAG);
    const int vb = (int)(size_t)Vl + v_rd_base(lane);
    float R = 1.0f; f32x16 o[4] = {};
    const int jmax = (t0 + 254) >> 6;
    const int jw = (t0 + wid * 32 + 30) >> 6;
    bool wdone = false;
    if (tid < 8) flags[tid] = 0u;
    Stage S; stage_load(S, Kp, Vp, jmax * 64, sr, sc); stage_write(S, Kl, Vl, kws, vst0, vst1);
    __syncthreads();
    int buf = 0;
    for (int j = jmax; j >= 0; --j) {
        if (j > 0) stage_load(S, Kp, Vp, (j - 1) * 64, sr, sc);
        if (!wdone && j <= jw) {
            f32x16 p0, p1; qkt(p0, p1, Kl + buf * SHM_T, r32, hi, qr);
            sb_math(p0, p1, R, tq - 64 * j - 4 * hi, 64 * j + 63 >= t0 + wid * 32, hi);
            bf16x8 pa0, pa1, pa2, pa3; pack_p(p0, p1, pa0, pa1, pa2, pa3);
            pv_tile(o, vb + buf * SHM_T, pa0, pa1, pa2, pa3);
#ifndef PROBE_NO_EXIT
            if (__all(R < 1e-30f)) { wdone = true; if (lane == 0) flags[wid] = 1u; }
#endif
        }
        if (j > 0) stage_write(S, Kl + (buf ^ 1) * SHM_T, Vl + (buf ^ 1) * SHM_T, kws, vst0, vst1);
        __syncthreads();
        buf ^= 1;
        if (j > 0) { const u32x4 f0 = *(const LAS u32x4*)flags, f1 = *(const LAS u32x4*)(flags + 4);
            if ((f0.x & f0.y & f0.z & f0.w & f1.x & f1.y & f1.z & f1.w) != 0u) break; }
    }
#ifdef PROBE_ZERO_SB
#pragma unroll
    for (int d = 0; d < 4; ++d) o[d] = f32x16{};
#endif
    store_o(o, nullptr, Op + (size_t)(wid * 32) * PITCH, r32, hi);
    __syncthreads();
}

__device__ __forceinline__ int t5_bucket(int n) {
    if (n < 16) return n;
    const int th[15] = {19, 21, 24, 27, 31, 35, 40, 46, 52, 59, 67, 77, 87, 99, 113};
    int bkt = 16;
#pragma unroll
    for (int i = 0; i < 15; ++i) bkt += (n >= th[i]) ? 1 : 0;
    return bkt;
}
__device__ __forceinline__ void dsa_block(const Frame& F, int b, int h, int qb, const bf16* Qb, const bf16* Kb, const bf16* Vb, bf16* Ob, const u64* BM, const float* relbias) {
    LAS char* lds = (LAS char*)F.lds;
    const int tid = F.tid, wid = F.wave, lane = F.lane, r32 = lane & 31, hi = lane >> 5;
    const int t0 = qb * 256, tq = t0 + wid * 32 + r32;
    const size_t rowbase = (size_t)b * SEQ;
    const bf16* Qp = Qb + (rowbase + t0) * PITCH + h * HD; bf16* Op = Ob + (rowbase + t0) * PITCH + h * HD;
    const bf16* Kp = Kb + rowbase * PITCH + h * HD; const bf16* Vp = Vb + rowbase * PITCH + h * HD;
    const u64* bmrow = BM + (rowbase + tq) * 128;
    bf16x8 qr[8];
#pragma unroll
    for (int d0 = 0; d0 < 8; ++d0) qr[d0] = *(const bf16x8*)(Qp + (size_t)(wid * 32 + r32) * PITCH + d0 * 16 + hi * 8);
    const int sr = tid >> 4, sc = (tid & 15) * 8, kws = KSWZ(sr, sc * 2), vst0 = v_st(sr, sc), vst1 = vst0 + 8192  ;
    LAS char* Vl = lds + OFF_V; LAS char* Kl = lds + OFF_K;
    LAS float* ws = (LAS float*)(lds + OFF_WS) + wid * 64; LAS float* li_l = ws; LAS float* al_l = ws + 32;
    LAS float* btab = (LAS float*)(lds + OFF_TAB);
    if (tid < 128) btab[tid] = relbias[t5_bucket(tid) * NHEAD + h] * LOG2E;
    const float bfar = relbias[31 * NHEAD + h] * LOG2E;
    const int vb = (int)(size_t)Vl + v_rd_base(lane);
    float m_reg = -1e30f, l_reg = 0.f; f32x16 o[4] = {};
    const int jmax = (t0 + 255) >> 6;
    const int jw = (t0 + wid * 32 + 31) >> 6;
    constexpr float C2 = QK_SCALE * LOG2E, THR2 = 8.0f * LOG2E, NEG = -__builtin_inff();
    Stage S; stage_load(S, Kp, Vp, 0, sr, sc); stage_write(S, Kl, Vl, kws, vst0, vst1);
    __syncthreads();
    int buf = 0;
    for (int j = 0; j <= jmax; ++j) {
        if (j < jmax) stage_load(S, Kp, Vp, (j + 1) * 64, sr, sc);
        if (j <= jw) {
            const u64 mw = bmrow[j];
#ifdef PROBE_ALL_NEAR
            const bool nearT = true;
#else
            const bool nearT = (t0 + wid * 32) - (64 * j + 63) < 113;
#endif
#define DSA_HALF(HALF) do { \
            f32x16 p; SBAR(); qkt_half<HALF>(p, Kl + buf * SHM_T, r32, hi, qr); SBAR(); \
            const unsigned mk = (unsigned)(mw >> (32 * HALF)) >> (4 * hi); \
            const int dq = tq - 64 * j - 32 * HALF - 4 * hi;             \
            if (nearT) { \
                _Pragma("unroll") for (int r = 0; r < 16; ++r) { const int c = (r & 3) + 8 * (r >> 2); int n0 = dq - c; n0 = n0 < 0 ? 0 : (n0 > 127 ? 127 : n0); \
                    const float x0 = p[r] * C2 + btab[n0]; p[r] = ((mk >> c) & 1u) ? x0 : NEG; } \
            } else { \
                _Pragma("unroll") for (int r = 0; r < 16; ++r) { const int c = (r & 3) + 8 * (r >> 2); const float x0 = p[r] * C2 + bfar; p[r] = ((mk >> c) & 1u) ? x0 : NEG; } \
            } \
            SBAR(); \
              \
            float pmax = p[0]; \
            _Pragma("unroll") for (int r = 1; r < 16; ++r) pmax = fmaxf(pmax, p[r]); \
            pmax = fmaxf(pmax, swap_other(pmax, hi)); \
            float mn, alpha; \
            if (__all(pmax - m_reg <= THR2)) { mn = m_reg; alpha = 1.0f; } \
            else { mn = fmaxf(m_reg, pmax); alpha = __builtin_amdgcn_exp2f(m_reg - mn); m_reg = mn; } \
            float ps = 0.f; \
            _Pragma("unroll") for (int r = 0; r < 16; ++r) { p[r] = __builtin_amdgcn_exp2f(p[r] - mn); ps += p[r]; } \
            ps += swap_other(ps, hi); \
            l_reg = l_reg * alpha + ps; SBAR(); \
            if (__any(alpha < 1.0f)) { if (hi == 0) al_l[r32] = alpha; LDS_WAIT(); \
                _Pragma("unroll") for (int r = 0; r < 16; ++r) { const float a = al_l[crow(r, hi)]; \
                    _Pragma("unroll") for (int d = 0; d < 4; ++d) o[d][r] *= a; } \
                LDS_WAIT(); } \
            SBAR(); bf16x8 pa0, pa1; pack_half(p, pa0, pa1); SBAR(); \
            pv_half<HALF>(o, vb + buf * SHM_T, pa0, pa1); SBAR(); } while (0)
            DSA_HALF(0);
            if (64 * j + 32 <= t0 + wid * 32 + 31) DSA_HALF(1);
#undef DSA_HALF
        }
        if (j < jmax) stage_write(S, Kl + (buf ^ 1) * SHM_T, Vl + (buf ^ 1) * SHM_T, kws, vst0, vst1);
        __syncthreads();
        buf ^= 1;
    }
    if (hi == 0) li_l[r32] = l_reg; LDS_WAIT();
    float rli[16];
#pragma unroll
    for (int r = 0; r < 16; ++r) rli[r] = __builtin_amdgcn_rcpf(li_l[crow(r, hi)]);
#ifdef PROBE_ZERO_DS
#pragma unroll
    for (int r = 0; r < 16; ++r) rli[r] = 0.f;
#endif
#ifdef PROBE_ZERO_DS_LATE
    if (t0 >= 256) {
#pragma unroll
    for (int r = 0; r < 16; ++r) rli[r] = 0.f; }
#endif
    store_o(o, rli, Op + (size_t)(wid * 32) * PITCH, r32, hi);
    __syncthreads();
}
#undef KSWZ
}

namespace idx {
__device__ __forceinline__ unsigned fkey(float s) {
    const _Float16 hh = (_Float16)s; unsigned bits = (unsigned)__builtin_bit_cast(unsigned short, hh);
#ifdef PROBE_COARSE_KEYS
    bits &= ~(unsigned)PROBE_COARSE_KEYS;
#endif
    return (bits & 0x8000u) ? (~bits & 0xffffu) : (bits | 0x8000u);
}
template <int CTRL> __device__ __forceinline__ int dpp_mov(int v) { return __builtin_amdgcn_update_dpp(0, v, CTRL, 0xf, 0xf, false); }
__device__ __forceinline__ int wave_sum_dpp(int x) {
    x += dpp_mov<0xB1>(x); x += dpp_mov<0x4E>(x); x += dpp_mov<0x141>(x); x += dpp_mov<0x140>(x);
    return __builtin_amdgcn_readlane(x, 0) + __builtin_amdgcn_readlane(x, 16) + __builtin_amdgcn_readlane(x, 32) + __builtin_amdgcn_readlane(x, 48);
}
__device__ __forceinline__ unsigned count_ge(const u32x4 (&dat)[16], int jn, unsigned cand) {
    const unsigned cm1 = __builtin_amdgcn_readfirstlane((cand - 1u) | ((cand - 1u) << 16)), one2 = 0x00010001u;
    unsigned acc = 0u;
#pragma unroll
    for (int j = 0; j < 16; ++j) if (j < jn) {
#pragma unroll
        for (int e = 0; e < 4; ++e) { unsigned d;
            asm volatile("v_pk_sub_u16 %0, %2, %3 clamp\n\tv_pk_min_u16 %0, %0, %4\n\tv_pk_add_u16 %1, %1, %0" : "=&v"(d), "+v"(acc) : "v"(dat[j][e]), "s"(cm1), "s"(one2)); } }
    return (unsigned)wave_sum_dpp((int)(acc & 0xffffu) + (int)(acc >> 16));
}
__device__ __forceinline__ void unit(const Frame& F, int b, int t0, const bf16* QIX, const bf16* KIX, const float* WIX, unsigned char* BM) {
    LAS unsigned short* SC = (LAS unsigned short*)F.lds;
    const int wave = F.wave, lane = F.lane, r32 = lane & 31, hi = lane >> 5;
    const size_t rowbase = (size_t)b * SEQ;
    const int ntile = (t0 + 8 + 31) >> 5;
    {
        bf16x8 af[4][4];
        LAS float* WL = (LAS float*)(F.lds + EXTRA_OFF);
        LAS unsigned short* QL = (LAS unsigned short*)(F.lds + EXTRA_OFF + 512);
        if (F.tid < 128) WL[F.tid] = WIX[(rowbase + t0) * NIH + F.tid];
        {   const int q = F.tid >> 6, d = F.tid & 63; float a = 0.f;
#pragma unroll
            for (int hd = 0; hd < NIH; ++hd) a = fmaf(WIX[(rowbase + t0 + q) * NIH + hd], (float)__builtin_bit_cast(_Float16, QIX[(rowbase + t0 + q) * WATT + hd * IDIM + d]), a);
            QL[q * IDIM + d] = __builtin_bit_cast(unsigned short, (_Float16)a); }
#pragma unroll
        for (int rt = 0; rt < 4; ++rt) { const int q = 2 * rt + ((r32 >> 2) & 1), hd = (r32 & 3) + 4 * (r32 >> 3);
#pragma unroll
            for (int ks = 0; ks < 4; ++ks) af[rt][ks] = *(const bf16x8*)(QIX + (rowbase + t0 + q) * WATT + hd * IDIM + ks * 16 + hi * 8);
        }
        __syncthreads();
        bf16x8 af5[4];
        {   const int q5 = 2 * (r32 & 3) + ((r32 >> 2) & 1);
#pragma unroll
            for (int ks = 0; ks < 4; ++ks) { u32x4 pk = *(const LAS u32x4*)(QL + q5 * IDIM + ks * 16 + hi * 8); if (r32 >= 8) pk = (u32x4){0u, 0u, 0u, 0u}; af5[ks] = __builtin_bit_cast(bf16x8, pk); }
        }
        bf16x8 bnx[4];
        if (wave < ntile) {
#pragma unroll
            for (int ks = 0; ks < 4; ++ks) bnx[ks] = *(const bf16x8*)(KIX + (rowbase + wave * 32) * IDIM + ((ks * 2 + hi) * 32 + r32) * 8); }
        for (int jt = wave; jt < ntile; jt += NWAVES) {
            const int key = jt * 32 + r32;
            bf16x8 bfr[4];
#pragma unroll
            for (int ks = 0; ks < 4; ++ks) bfr[ks] = bnx[ks];
            if (jt + NWAVES < ntile) {
#pragma unroll
                for (int ks = 0; ks < 4; ++ks) bnx[ks] = *(const bf16x8*)(KIX + (rowbase + (jt + NWAVES) * 32) * IDIM + ((ks * 2 + hi) * 32 + r32) * 8); }
            f32x16 acc5 = {};
#pragma unroll
            for (int ks = 0; ks < 4; ++ks) acc5 = MFMA32(af5[ks], bfr[ks], acc5);
#pragma unroll
            for (int rt = 0; rt < 4; ++rt) {
                f32x16 acc = {};
#pragma unroll
                for (int ks = 0; ks < 4; ++ks) acc = MFMA32(af[rt][ks], bfr[ks], acc);
                float s = acc5[rt];
                f32x4 wq4[4];
#pragma unroll
                for (int i = 0; i < 4; ++i) wq4[i] = *(const LAS f32x4*)(WL + (2 * rt + hi) * NIH + 4 * i);
#pragma unroll
                for (int r = 0; r < 16; ++r) s = fmaf(wq4[r >> 2][r & 3], fabsf(acc[r]), s);
                const int q = 2 * rt + hi;
                SC[q * 8192 + key] = (unsigned short)((key <= t0 + q) ? fkey(s) : 0u);
            }
        }
    }
    __syncthreads();
    {
        const int t = t0 + wave, nch = ntile * 4, jn = (nch + 63) >> 6;
        u32x4 dat[16];
#pragma unroll
        for (int j = 0; j < 16; ++j) { const int c = j * 64 + lane; dat[j] = (c < nch) ? *(const LAS u32x4*)(SC + wave * 8192 + c * 8) : (u32x4){0u, 0u, 0u, 0u}; }
        unsigned T = 0u; int need = 0;
        if (t >= TOPK) {
            for (int bit = 15; bit >= 0; --bit) { const unsigned cand = T | (1u << bit); if (count_ge(dat, jn, cand) >= (unsigned)TOPK) T = cand; }
            const unsigned cgt = (T == 0xffffu) ? 0u : count_ge(dat, jn, T + 1u);
            need = TOPK - (int)cgt;
        }
        int taken = 0;
#pragma unroll
        for (int j = 0; j < 16; ++j) if (j < jn) {
            const int c = j * 64 + lane;
            unsigned gm = 0u, tm = 0u;
#pragma unroll
            for (int i = 0; i < 8; ++i) { const unsigned k = (dat[j][i >> 1] >> (16 * (i & 1))) & 0xffffu; gm |= (k > T ? 1u : 0u) << i; tm |= (k == T ? 1u : 0u) << i; }
            unsigned byte = gm;
            if (need > taken && __any(tm != 0u)) {
                const int cnt = __builtin_popcount(tm);
                int inc = cnt;
#pragma unroll
                for (int o = 1; o < 64; o <<= 1) { const int v = __shfl_up(inc, o); if (lane >= o) inc += v; }
                const int tot = __shfl(inc, 63);
                int allow = need - taken - (inc - cnt); allow = allow < 0 ? 0 : (allow > 8 ? 8 : allow);
                unsigned tsel = 0u; int k = 0;
#pragma unroll
                for (int i = 0; i < 8; ++i) { const unsigned bt = (tm >> i) & 1u; if (bt && k < allow) tsel |= 1u << i; k += (int)bt; }
                byte |= tsel;
                taken += (tot < need - taken) ? tot : (need - taken);
            }
            if (c < nch) BM[(rowbase + t) * 1024 + c] = (unsigned char)byte;
        }
    }
    __syncthreads();
}
}

__device__ __forceinline__ void conv_fixup(const Frame& F, const float* ghalo, const float* gdef, const float* udef, const float* convw, const float* convb, bf16* act) {
    const int nth = F.G * NWAVES * 64, gt = F.vcu * NWAVES * 64 + F.tid;
    for (int id = gt; id < 512 * (FF / 4); id += nth) {
        const int rowi = id / (FF / 4), f = 4 * (id % (FF / 4)), blk = rowi >> 1, i = rowi & 1;
        const bool first = (blk & 127) == 0;
        const f32x4 z = {0.f, 0.f, 0.f, 0.f};
        const f32x4 g = *(const f32x4*)(gdef + (size_t)rowi * FF + f), u = *(const f32x4*)(udef + (size_t)rowi * FF + f);
        f32x4 g1, g2;
        if (i == 0) { g1 = first ? z : *(const f32x4*)(ghalo + (size_t)((blk - 1) * 2 + 1) * FF + f); g2 = first ? z : *(const f32x4*)(ghalo + (size_t)((blk - 1) * 2) * FF + f); }
        else { g1 = *(const f32x4*)(gdef + (size_t)(blk * 2) * FF + f); g2 = first ? z : *(const f32x4*)(ghalo + (size_t)((blk - 1) * 2 + 1) * FF + f); }
        const f32x4 w0 = *(const f32x4*)(convw + f), w1 = *(const f32x4*)(convw + FF + f), w2 = *(const f32x4*)(convw + 2 * FF + f), cb = *(const f32x4*)(convb + f);
        f32x4 r;
#pragma unroll
        for (int e = 0; e < 4; ++e) { const float a = cb[e] + w0[e] * g2[e] + w1[e] * g1[e] + w2[e] * g[e]; r[e] = a * pg8::sigmoidf_fast(a) * u[e]; }
        u32x2 w; w.x = cvtpk(r[0], r[1]); w.y = cvtpk(r[2], r[3]);
        *(u32x2*)(act + (size_t)(blk * 64 + i) * FF + f) = w;
    }
}

struct Args { const float* in[17]; float* out; unsigned char* ws; int ph_lo, ph_hi; };
__global__ void __launch_bounds__(NWAVES * 64, 2) mk_fwd(Args args) {
    extern __shared__ __attribute__((aligned(16))) unsigned char lds[];
#define FRAME(F) Frame F; { int l_; asm volatile("v_mbcnt_lo_u32_b32 %0, -1, 0\n\tv_mbcnt_hi_u32_b32 %0, -1, %0" : "=v"(l_)); F.lds = (LAS unsigned char*)lds; F.MISC = (volatile LAS unsigned*)(F.lds + MISC_OFF); \
        F.wave = wave0; F.lane = l_; F.tid = wave0 * 64 + l_; F.G = gridDim.x; const int bx_ = blockIdx.x; F.vcu = (F.G % 8 == 0) ? (bx_ % 8) * (F.G / 8) + bx_ / 8 : bx_; }
    const int wave0 = __builtin_amdgcn_readfirstlane((int)threadIdx.x >> 6);
    FRAME(F0);
    unsigned char* ws = args.ws;
    gu32* ctl = (gu32*)(ws + WS_CTL);
    for (int u = F0.tid; u < (LDS_BYTES - LDSCTL_OFF) / 4; u += NWAVES * 64) ((LAS unsigned*)(F0.lds + LDSCTL_OFF))[u] = 0u;
    __syncthreads();
    if (N_LAUNCHES == 1) (void)xcd_barrier_post((unsigned*)(ctl + CW_BAR), F0.MISC + 8, F0.tid == 0);
#define GRID_BAR() do { if (N_LAUNCHES == 1) { XcdBarrier b_; b_.bar = (unsigned*)((gu32*)(ws + WS_CTL) + CW_BAR); b_.x = xb_xcc_id(); b_.st = F.MISC + 8; xcd_barrier(b_, F.tid == 0); } } while (0)
    const int lo = (N_LAUNCHES == 1) ? 0 : args.ph_lo, hi = (N_LAUNCHES == 1) ? NPH : args.ph_hi;
#ifndef PH_MASK
#define PH_MASK 0xfff
#endif
#define IN(k) (((PH_MASK >> (k)) & 1) && lo <= (k) && (k) < hi)
#define BOTH(k) ((IN(k) && IN((k) + 1)) || rep_ + 1 < DUPN(k))
#ifdef PROBE_DUP
#define DUPN(k) ((k) == PROBE_DUP ? 2 : 1)
#define DUPOUT(k, real) ((PROBE_DUP == (k) && rep_ == 0) ? (bf16*)(w + WS_H) : (real))
#else
#define DUPN(k) 1
#define DUPOUT(k, real) (real)
#endif

    float* out = args.out;
#define WSP(name) unsigned char* name = ws; int zq = 0; asm volatile("" : "+s"(name), "+s"(zq)); FRAME(F)
#define MODP(w) ((float*)((w) + WS_MOD))
#define SEGP(w, i) ((bf16*)((w) + WS_SEG) + (size_t)(i) * (SEG_BYTES / 2))

    for (int rep_ = 0; rep_ < DUPN(0); ++rep_) if (IN(0)) { WSP(w);
        ph0_mod(F, args.in[1 + zq], args.in[2 + zq], args.in[3 + zq], MODP(w));
        WPtrs P{args.in[5 + zq], args.in[6 + zq], args.in[7 + zq], args.in[8 + zq], args.in[11 + zq], args.in[12 + zq], args.in[15 + zq], (bf16*)(w + WS_WIN), (bf16*)(w + WS_WOSB), (bf16*)(w + WS_WODS), (bf16*)(w + WS_WOUT), (bf16*)(w + WS_WGU), (bf16*)(w + WS_WDN)};
        ph0_weights(F, P);
        if (BOTH(0)) GRID_BAR();
    }
    for (int rep_ = 0; rep_ < DUPN(1); ++rep_) if (IN(1)) { WSP(w); norm_mod_rows(F, args.in[0 + zq], (bf16*)(w + WS_H), args.in[4 + zq], MODP(w) + 0 * DM, MODP(w) + 1 * DM); if (BOTH(1)) GRID_BAR(); }
    for (int rep_ = 0; rep_ < DUPN(2); ++rep_) if (IN(2)) { WSP(w);
        pg8::Gemm g{(bf16*)(w + WS_H), (bf16*)(w + WS_WIN), (bf16*)(w + WS_H), (bf16*)(w + WS_WIN), DM}; pg8::TileOrder S; S.init(MROWS / 256, N_IN_PAD / 256, 1, F.G, (int)blockIdx.x);
        pg8::EpiIn E{SEGP(w, 0), SEG_BYTES / 2, (bf16*)out, (bf16*)(w + WS_KIX), (float*)(w + WS_WIX), 0.25f * 0.125f};
        pg8::gemm_phase<pg8::EpiIn, pg8::TileOrder, true, true>(F.lds + RING_OFF, g, S, E, F.tid);
        if (BOTH(2)) GRID_BAR();
    }
    for (int rep_ = 0; rep_ < DUPN(3); ++rep_) if (IN(3)) { WSP(w);
#ifdef PROBE_DUP_IDX_ONLY
        if (rep_ == DUPN(3) - 1)
#endif
        for (int u = F.vcu; u < 2 * NHEAD * 32; u += F.G) { const int bh = u >> 5, qb = u & 31; att::sb_block(F, bh >> 3, bh & 7, qb, SEGP(w, 0), SEGP(w, 1), SEGP(w, 2), DUPOUT(3, SEGP(w, 0))); }
        for (int i = 0; i * F.G < BATCH * SEQ / 8; ++i) { const int id = i * F.G + ((i & 1) ? (F.G - 1 - F.vcu) : F.vcu);
            if (id < BATCH * SEQ / 8) idx::unit(F, id & 1, (id >> 1) * 8, SEGP(w, 6), (const bf16*)(w + WS_KIX), (const float*)(w + WS_WIX), w + WS_BM); }
        if (BOTH(3)) GRID_BAR();
    }
    for (int rep_ = 0; rep_ < DUPN(4); ++rep_) if (IN(4)) { WSP(w);
        for (int it = F.vcu; it < 2 * NHEAD * 16; it += F.G) { const int bh = it >> 4, p = it & 15;
            att::dsa_block(F, bh >> 3, bh & 7, 31 - p, SEGP(w, 3), SEGP(w, 4), SEGP(w, 5), DUPOUT(4, SEGP(w, 3)), (const u64*)(w + WS_BM), args.in[9 + zq]);
            att::dsa_block(F, bh >> 3, bh & 7, p, SEGP(w, 3), SEGP(w, 4), SEGP(w, 5), DUPOUT(4, SEGP(w, 3)), (const u64*)(w + WS_BM), args.in[9 + zq]); }
        if (BOTH(4)) GRID_BAR();
    }
    for (int rep_ = 0; rep_ < DUPN(5); ++rep_) if (IN(5)) { WSP(w);
        pg8::Gemm g{SEGP(w, 0), (bf16*)(w + WS_WOSB), SEGP(w, 3), (bf16*)(w + WS_WODS), WATT}; pg8::TileOrder S; S.init(MROWS / 256, DM / 256, 2, F.G, (int)blockIdx.x);
        pg8::EpiMerged E{(const bf16*)out, (bf16*)(w + WS_H)};
        pg8::gemm_phase<pg8::EpiMerged, pg8::TileOrder, true, true>(F.lds + RING_OFF, g, S, E, F.tid);
        if (BOTH(5)) GRID_BAR();
    }
    for (int rep_ = 0; rep_ < DUPN(6); ++rep_) if (IN(6)) { WSP(w);
        pg8::Gemm g{(bf16*)(w + WS_H), (bf16*)(w + WS_WOUT), (bf16*)(w + WS_H), (bf16*)(w + WS_WOUT), DM}; pg8::TileOrder S; S.init(MROWS / 256, DM / 256, 1, F.G, (int)blockIdx.x);
        pg8::EpiResid E{args.in[0 + zq], out, MODP(w) + 2 * DM, 6 * DM};
        pg8::gemm_phase<pg8::EpiResid, pg8::TileOrder, true, true>(F.lds + RING_OFF, g, S, E, F.tid);
        if (BOTH(6)) GRID_BAR();
    }
    for (int rep_ = 0; rep_ < DUPN(7); ++rep_) if (IN(7)) { WSP(w); norm_mod_rows(F, out, (bf16*)(w + WS_H), args.in[10 + zq], MODP(w) + 3 * DM, MODP(w) + 4 * DM); if (BOTH(7)) GRID_BAR(); }
    for (int rep_ = 0; rep_ < DUPN(8); ++rep_) if (IN(8)) { WSP(w);
        pg8::Gemm g{(bf16*)(w + WS_H), (bf16*)(w + WS_WGU), (bf16*)(w + WS_H), (bf16*)(w + WS_WGU), DM}; pg8::TileOrder S; S.init(MROWS / 256, 2 * FF / 256, 1, F.G, (int)blockIdx.x);
        pg8::EpiGU E{(bf16*)(w + WS_ACT), (float*)(w + WS_GHALO), (float*)(w + WS_GDEF), (float*)(w + WS_UDEF), args.in[13 + zq], args.in[14 + zq]};
        pg8::gemm_phase<pg8::EpiGU, pg8::TileOrder, true, true>(F.lds + RING_OFF, g, S, E, F.tid);
        if (BOTH(8)) GRID_BAR();
    }
    for (int rep_ = 0; rep_ < DUPN(9); ++rep_) if (IN(9)) { WSP(w); conv_fixup(F, (const float*)(w + WS_GHALO), (const float*)(w + WS_GDEF), (const float*)(w + WS_UDEF), args.in[13 + zq], args.in[14 + zq], (bf16*)(w + WS_ACT)); if (BOTH(9)) GRID_BAR(); }
#ifndef PROBE_ZERO_FFN
    for (int rep_ = 0; rep_ < DUPN(10); ++rep_) if (IN(10)) { WSP(w);
        pg8::Gemm g{(bf16*)(w + WS_ACT), (bf16*)(w + WS_WDN), (bf16*)(w + WS_ACT), (bf16*)(w + WS_WDN), FF}; pg8::TileOrder S; S.init(MROWS / 256, DM / 256, 1, F.G, (int)blockIdx.x);
        pg8::EpiResid E{out, out, MODP(w) + 5 * DM, 6 * DM};
        pg8::gemm_phase<pg8::EpiResid, pg8::TileOrder, true, true>(F.lds + RING_OFF, g, S, E, F.tid);
        if (BOTH(10)) GRID_BAR();
    }
#endif
    if (IN(11)) { int zq = 0; asm volatile("" : "+s"(zq)); FRAME(F); norm_final_rows(F, out, args.in[16 + zq]); }
#undef IN
#undef BOTH
#undef GRID_BAR
}

extern "C" void kernel_launch(void* const* d_in, const int* in_sizes, int n_in, void* d_out, int out_size, void* d_ws, size_t ws_size, hipStream_t stream) {
    static int grid = 0;
    if (grid == 0) {
        if (n_in != 17 || in_sizes[0] != MROWS * DM || out_size != MROWS * DM || ws_size < WS_END) { fprintf(stderr, "kernel_launch: unexpected shapes (n_in %d, in0 %d, out %d, ws %zu); nothing launched\n", n_in, n_in > 0 ? in_sizes[0] : -1, out_size, ws_size); grid = -1; return; }
        int dev = 0, cus = 0, per_cu = 0;
        if (hipGetDevice(&dev) != hipSuccess || hipDeviceGetAttribute(&cus, hipDeviceAttributeMultiprocessorCount, dev) != hipSuccess) { grid = -1; return; }
        if (hipFuncSetAttribute((const void*)mk_fwd, hipFuncAttributeMaxDynamicSharedMemorySize, LDS_BYTES) != hipSuccess) { fprintf(stderr, "kernel_launch: hipFuncSetAttribute failed\n"); grid = -1; return; }
        if (hipOccupancyMaxActiveBlocksPerMultiprocessor(&per_cu, (const void*)mk_fwd, NWAVES * 64, LDS_BYTES) != hipSuccess || per_cu < 1)
            fprintf(stderr, "kernel_launch: note: occupancy query reports %d workgroups per CU\n", per_cu);
        (void)hipGetLastError();
        grid = cus;
    }
    if (grid < 0) return;
    if (hipMemsetAsync((char*)d_ws + WS_CTL, 0, ZERO_BYTES, stream) != hipSuccess) { fprintf(stderr, "kernel_launch: memset failed\n"); return; }
    Args a{};
    for (int i = 0; i < 17; ++i) a.in[i] = (const float*)d_in[i];
    a.out = (float*)d_out; a.ws = (unsigned char*)d_ws;
    for (int li = 0; li < N_LAUNCHES; ++li) {
        a.ph_lo = (N_LAUNCHES == 1) ? 0 : li; a.ph_hi = (N_LAUNCHES == 1) ? NPH : li + 1;
        hipLaunchKernelGGL(mk_fwd, dim3(grid), dim3(NWAVES * 64), LDS_BYTES, stream, a);
        const hipError_t le = hipPeekAtLastError();
        if (le != hipSuccess) { fprintf(stderr, "kernel_launch: launch %d failed: %s\n", li, hipGetErrorName(le)); break; }
    }
}
```

```cpp
#include <hip/hip_runtime.h>
#include <cstdio>
#include <cstdint>

#define WEIGHTS_ALL_IN_P0 1
#ifndef MK_N_LAUNCHES
#define MK_N_LAUNCHES 1
#endif

namespace pg8 {
#define PG8_LAS __attribute__((address_space(3)))
typedef unsigned short bf16_t;
typedef short bf16x8 __attribute__((ext_vector_type(8)));
typedef float f32x4 __attribute__((ext_vector_type(4)));
typedef unsigned u32x4 __attribute__((ext_vector_type(4)));
typedef unsigned u32x2 __attribute__((ext_vector_type(2)));
constexpr int BM = 256, BK = 64, HALF = 128, HTB = HALF * BK * 2  , STAGE_BYTES = 8 * HTB, NXCD = 8, WGM = 8;

__host__ __device__ __forceinline__ int lds_byte(int r, int c) { const int st = (r >> 4) * 2 + (c >> 5), rr = r & 15, cc = c & 31, ob = rr * 64 + cc * 2; return st * 1024 + (ob ^ (((ob >> 9) & 1) << 5)); }
__host__ __device__ __forceinline__ void stage_rc(int b, int& R, int& C) { const int st = b / 1024, sb = b % 1024, swz = sb ^ (((sb >> 9) & 1) << 5); R = (st >> 1) * 16 + swz / 64; C = (st & 1) * 32 + (swz % 64) / 2; }
__host__ __device__ __forceinline__ int perm32(int rho) { const int n = rho >> 4, i = rho & 15; return 8 * (i >> 2) + 4 * n + (i & 3); }

struct Unit { int pm, pn, part; };
struct Gemm { const bf16_t* A; const bf16_t* Bt; const bf16_t* A2; const bf16_t* Bt2; int K; };

struct TileOrder {
    int nM, nN, nwg, G, c, parts;
    __host__ __device__ void init(int nM_, int nN_, int parts_, int G_, int c_) { nM = nM_; nN = nN_; nwg = nM * nN; G = G_; c = c_; parts = parts_; }
    __host__ __device__ bool next(int i, Unit& u) const {
        const int ti = (parts == 2) ? (i >> 1) : i; u.part = (parts == 2) ? (i & 1) : 0;
        const long L = (long)ti * G + c; if (L >= nwg) return false;
        int wgid = (int)L; { const int q = nwg / NXCD, r = nwg % NXCD, xcd = wgid % NXCD, off = wgid / NXCD; wgid = (xcd < r ? xcd * (q + 1) : r * (q + 1) + (xcd - r) * q) + off; }
        const int nig = WGM * nN, gid = wgid / nig, fm = gid * WGM, gsz = (nM - fm) < WGM ? (nM - fm) : WGM;
        u.pm = fm + ((wgid % nig) % gsz); u.pn = (wgid % nig) / gsz; return true;
    }
};

typedef _Float16 h16x2 __attribute__((ext_vector_type(2)));
typedef _Float16 h16x8 __attribute__((ext_vector_type(8)));
typedef int i32x8 __attribute__((ext_vector_type(8)));
typedef int i32x4q __attribute__((ext_vector_type(4)));
typedef float f32x2c __attribute__((ext_vector_type(2)));
__device__ __forceinline__ unsigned cvt_pk_bf16(float lo, float hi) { return __builtin_bit_cast(unsigned, __builtin_convertvector((f32x2c){lo, hi}, h16x2)); }
__device__ __forceinline__ float bf_lo(unsigned w) { return (float)__builtin_bit_cast(h16x2, w)[0]; }
__device__ __forceinline__ float bf_hi(unsigned w) { return (float)__builtin_bit_cast(h16x2, w)[1]; }
__device__ __forceinline__ float sigmoidf_fast(float x) { return __builtin_amdgcn_rcpf(1.0f + __builtin_amdgcn_exp2f(-1.4426950408889634f * x)); }
__device__ __forceinline__ u32x4 pack8(const f32x4& v0, const f32x4& v1) { u32x4 w; w.x = cvt_pk_bf16(v0[0], v0[1]); w.y = cvt_pk_bf16(v0[2], v0[3]); w.z = cvt_pk_bf16(v1[0], v1[1]); w.w = cvt_pk_bf16(v1[2], v1[3]); return w; }

typedef unsigned u32x2e __attribute__((ext_vector_type(2)));
struct EpiIn {
    static constexpr bool PERM = true;
    bf16_t* seg0; size_t seg_stride; unsigned char* gates; bf16_t* kix; float* wix; float wscale;
    __device__ __forceinline__ bool keep(const Unit&) const { return false; }
    __device__ __forceinline__ void operator()(f32x4 (&acc)[2][2][4][2], const Unit& u, int wr, int wc, int fr, int fq) const {
        const int row0 = u.pm * BM + wr * 64 + fr;
        if (u.pn < 44) {
            const bool gate = u.pn >= 28;
            bf16_t* base = seg0 + (size_t)((u.pn >> 2) == 2 ? 6 : (u.pn >> 2)) * seg_stride;
            const int col0 = (gate ? (u.pn - 28) * BM : (u.pn & 3) * BM) + wc * 32 + 8 * fq;
#pragma unroll
            for (int ai = 0; ai < 2; ++ai)
#pragma unroll
                for (int m = 0; m < 4; ++m) { const size_t row = (size_t)(row0 + ai * HALF + m * 16);
#pragma unroll
                    for (int bj = 0; bj < 2; ++bj) { f32x4 v0 = acc[ai][bj][m][0], v1 = acc[ai][bj][m][1];
                        if (gate) {
                            unsigned lo = 0u, hi = 0u;
#pragma unroll
                            for (int e = 0; e < 4; ++e) { lo |= (unsigned)(sigmoidf_fast(v0[e]) * 255.f + 0.5f) << (8 * e); hi |= (unsigned)(sigmoidf_fast(v1[e]) * 255.f + 0.5f) << (8 * e); }
                            u32x2e w2; w2.x = lo; w2.y = hi; *(u32x2e*)(gates + row * 4096 + col0 + bj * HALF) = w2; }
                        else *(u32x4*)(base + row * 1024 + col0 + bj * HALF) = pack8(v0, v1); } }
        } else {
#pragma unroll
            for (int ai = 0; ai < 2; ++ai)
#pragma unroll
                for (int m = 0; m < 4; ++m) { const size_t row = (size_t)(row0 + ai * HALF + m * 16); const f32x4 v0 = acc[ai][0][m][0], v1 = acc[ai][0][m][1];
                    if (wc < 2) *(u32x4*)(kix + (row >> 5) * 2048 + ((wc * 4 + fq) * 32 + (row & 31)) * 8) = pack8(v0, v1);
                    else if (wc == 2 && fq < 2) { float* p = wix + row * 16 + 8 * fq; *(f32x4*)p = v0 * wscale; *(f32x4*)(p + 4) = v1 * wscale; } }
        }
    }
};

struct EpiGate {
    static constexpr bool PERM = true;
    unsigned char* gates; const float* sa; bf16_t* vds; size_t vstride;
    __device__ __forceinline__ bool keep(const Unit&) const { return false; }
    __device__ __forceinline__ void operator()(f32x4 (&acc)[2][2][4][2], const Unit& u, int wr, int wc, int fr, int fq) const {
        const bool isv = u.pn >= 16;
        unsigned char* base = isv ? (unsigned char*)(vds + (size_t)((u.pn - 16) >> 2) * vstride + (size_t)((u.pn - 16) & 3) * BM) : gates + (size_t)u.pn * BM;
        const unsigned pitch = isv ? 2048u : 4096u, esz = isv ? 2u : 1u;
        const unsigned lo_ = (unsigned)(u.pm * BM + wr * 64 + fr) * pitch + (unsigned)(wc * 32 + 8 * fq) * esz;
#pragma unroll
        for (int ai = 0; ai < 2; ++ai)
#pragma unroll
            for (int m = 0; m < 4; ++m)
#pragma unroll
                for (int bj = 0; bj < 2; ++bj) { const float sr = sa[u.pm * BM + ai * HALF + wr * 64 + m * 16 + fr];
                    const i32x4q i0 = __builtin_bit_cast(i32x4q, acc[ai][bj][m][0]), i1 = __builtin_bit_cast(i32x4q, acc[ai][bj][m][1]);
                    const f32x4 v0 = (f32x4){(float)i0[0], (float)i0[1], (float)i0[2], (float)i0[3]} * sr, v1 = (f32x4){(float)i1[0], (float)i1[1], (float)i1[2], (float)i1[3]} * sr;
                    unsigned char* p = base + (lo_ + (unsigned)(ai * HALF + m * 16) * pitch + (unsigned)(bj * HALF) * esz);
                    if (isv) *(u32x4*)p = pack8(v0, v1);
                    else { unsigned lo = 0u, hi = 0u;
#pragma unroll
                        for (int e = 0; e < 4; ++e) { lo |= (unsigned)(sigmoidf_fast(v0[e]) * 255.f + 0.5f) << (8 * e); hi |= (unsigned)(sigmoidf_fast(v1[e]) * 255.f + 0.5f) << (8 * e); }
                        u32x2e w2; w2.x = lo; w2.y = hi; *(u32x2e*)p = w2; } }
    }
};

struct EpiMerged {
    static constexpr bool PERM = true;
    const unsigned char* gates; bf16_t* out;
    __device__ __forceinline__ bool keep(const Unit& u) const { return u.part == 0; }
    __device__ __forceinline__ void operator()(f32x4 (&acc)[2][2][4][2], const Unit& u, int wr, int wc, int fr, int fq) const {
        const int row0 = u.pm * BM + wr * 64 + fr, col0 = u.pn * BM + wc * 32 + 8 * fq;
        const int psel = (u.part == 0) ? 0 : 2048;
#pragma unroll
        for (int ai = 0; ai < 2; ++ai) {
#pragma unroll
          for (int mh = 0; mh < 2; ++mh) {
            u32x2e gs[4][2], gd[4][2];
#pragma unroll
            for (int m = 2 * mh; m < 2 * mh + 2; ++m)
#pragma unroll
                for (int bj = 0; bj < 2; ++bj) { const size_t off = (size_t)(row0 + ai * HALF + m * 16) * 4096 + col0 + bj * HALF; gd[m][bj] = *(const u32x2e*)(gates + off + 2048);
                    gs[m][bj] = *(const u32x2e*)(gates + off + psel); }
            asm volatile("" ::: "memory");
#pragma unroll
            for (int m = 2 * mh; m < 2 * mh + 2; ++m) { const size_t row = (size_t)(row0 + ai * HALF + m * 16);
#pragma unroll
                for (int bj = 0; bj < 2; ++bj) { const int col = col0 + bj * HALF;
                    float fs[8], fd[8];
#pragma unroll
                    for (int e = 0; e < 4; ++e) { constexpr float Q = 1.0f / 255.0f;
                        fs[e] = (float)((gs[m][bj].x >> (8 * e)) & 0xffu) * Q; fs[4 + e] = (float)((gs[m][bj].y >> (8 * e)) & 0xffu) * Q;
                        fd[e] = fmaxf((float)((gd[m][bj].x >> (8 * e)) & 0xffu) * Q, 1e-20f); fd[4 + e] = fmaxf((float)((gd[m][bj].y >> (8 * e)) & 0xffu) * Q, 1e-20f); }
                    f32x4 v0 = acc[ai][bj][m][0], v1 = acc[ai][bj][m][1];
                    if (u.part == 0) {
#pragma unroll
                        for (int e = 0; e < 4; ++e) { v0[e] *= fs[e] * __builtin_amdgcn_rcpf(fd[e]); v1[e] *= fs[4 + e] * __builtin_amdgcn_rcpf(fd[4 + e]); }
                        acc[ai][bj][m][0] = v0; acc[ai][bj][m][1] = v1;
                    } else {
#pragma unroll
                        for (int e = 0; e < 4; ++e) { v0[e] *= fd[e]; v1[e] *= fd[4 + e]; }
                        *(u32x4*)(out + row * 2048 + col) = pack8(v0, v1);
                    } } }
            asm volatile("" ::: "memory");
          }
        }
    }
};

struct EpiResid {
    static constexpr bool PERM = false;
    const float* base; float* out; const float* gt;
    int gstride;
    __device__ __forceinline__ bool keep(const Unit&) const { return false; }
    __device__ __forceinline__ void operator()(f32x4 (&acc)[2][2][4][2], const Unit& u, int wr, int wc, int fr, int fq) const {
        const int row0 = u.pm * BM + wr * 64 + fr, col0 = u.pn * BM + wc * 32 + 4 * fq;
        const float* g = gt + (size_t)(u.pm >> 5) * gstride;
#pragma unroll
        for (int bj = 0; bj < 2; ++bj) {
#pragma unroll
            for (int n = 0; n < 2; ++n) { f32x4 bs[2][4]; const f32x4 gv = *(const f32x4*)(g + col0 + bj * HALF + n * 16);
#pragma unroll
                for (int ai = 0; ai < 2; ++ai)
#pragma unroll
                    for (int m = 0; m < 4; ++m) bs[ai][m] = *(const f32x4*)(base + (size_t)(row0 + ai * HALF + m * 16) * 2048 + col0 + bj * HALF + n * 16);
                asm volatile("" ::: "memory");
#pragma unroll
                for (int ai = 0; ai < 2; ++ai)
#pragma unroll
                    for (int m = 0; m < 4; ++m) *(f32x4*)(out + (size_t)(row0 + ai * HALF + m * 16) * 2048 + col0 + bj * HALF + n * 16) = bs[ai][m] + gv * acc[ai][bj][m][n];
                asm volatile("" ::: "memory"); }
        }
    }
};

template <bool ACC> struct EpiDelta {
    static constexpr bool PERM = true;
    bf16_t* out; const float* gt; int gstride;
    __device__ __forceinline__ bool keep(const Unit&) const { return false; }
    __device__ __forceinline__ void operator()(f32x4 (&acc)[2][2][4][2], const Unit& u, int wr, int wc, int fr, int fq) const {
        const int row0 = u.pm * BM + wr * 64 + fr, col0 = u.pn * BM + wc * 32 + 8 * fq;
        const float* g = gt + (size_t)(u.pm >> 5) * gstride;
#pragma unroll
        for (int bj = 0; bj < 2; ++bj) { const f32x4 g0 = *(const f32x4*)(g + col0 + bj * HALF), g1 = *(const f32x4*)(g + col0 + bj * HALF + 4);
            u32x4 old[2][4];
            if (ACC) {
#pragma unroll
                for (int ai = 0; ai < 2; ++ai)
#pragma unroll
                    for (int m = 0; m < 4; ++m) old[ai][m] = *(const u32x4*)(out + (size_t)(row0 + ai * HALF + m * 16) * 2048 + col0 + bj * HALF);
                asm volatile("" ::: "memory"); }
#pragma unroll
            for (int ai = 0; ai < 2; ++ai)
#pragma unroll
                for (int m = 0; m < 4; ++m) { f32x4 v0 = g0 * acc[ai][bj][m][0], v1 = g1 * acc[ai][bj][m][1];
                    if (ACC) { const u32x4 o = old[ai][m]; v0 += (f32x4){bf_lo(o.x), bf_hi(o.x), bf_lo(o.y), bf_hi(o.y)}; v1 += (f32x4){bf_lo(o.z), bf_hi(o.z), bf_lo(o.w), bf_hi(o.w)}; }
                    *(u32x4*)(out + (size_t)(row0 + ai * HALF + m * 16) * 2048 + col0 + bj * HALF) = pack8(v0, v1); }
            asm volatile("" ::: "memory"); }
    }
};

__device__ __forceinline__ float dpp_ror1(float v) { return __int_as_float(__builtin_amdgcn_update_dpp(0, __float_as_int(v), 0x121, 0xf, 0xf, false)); }
__device__ __forceinline__ float dpp_ror2(float v) { return __int_as_float(__builtin_amdgcn_update_dpp(0, __float_as_int(v), 0x122, 0xf, 0xf, false)); }
template <bool I8 = false> struct EpiGU {
    static constexpr bool PERM = true;
    bf16_t* act; float* ghalo; float* gdef; float* udef; const float* convw; const float* convb;
    const float* sa;
    __device__ __forceinline__ bool keep(const Unit&) const { return false; }
    __device__ __forceinline__ void operator()(f32x4 (&acc)[2][2][4][2], const Unit& u, int wr, int wc, int fr, int fq) const {
        constexpr int FF = 5632;
        if (I8) {
#pragma unroll
            for (int ai = 0; ai < 2; ++ai)
#pragma unroll
                for (int m = 0; m < 4; ++m) { const float sr = sa[u.pm * BM + ai * HALF + wr * 64 + m * 16 + fr];
#pragma unroll
                    for (int bj = 0; bj < 2; ++bj)
#pragma unroll
                        for (int n = 0; n < 2; ++n) { const i32x4q iv = __builtin_bit_cast(i32x4q, acc[ai][bj][m][n]); acc[ai][bj][m][n] = (f32x4){(float)iv[0], (float)iv[1], (float)iv[2], (float)iv[3]} * sr; } } }
        const int f0 = u.pn * HALF + wc * 32 + 8 * fq;
        f32x4 w0[2], w1[2], w2[2], cb[2];
#pragma unroll
        for (int n = 0; n < 2; ++n) { w0[n] = *(const f32x4*)(convw + f0 + 4 * n); w1[n] = *(const f32x4*)(convw + FF + f0 + 4 * n); w2[n] = *(const f32x4*)(convw + 2 * FF + f0 + 4 * n); cb[n] = *(const f32x4*)(convb + f0 + 4 * n); }
#pragma unroll
        for (int ai = 0; ai < 2; ++ai) {
            const int rb = u.pm * BM + ai * HALF + wr * 64, blk = rb >> 6;
#pragma unroll
            for (int m = 0; m < 4; ++m) {
                f32x4 res[2];
#pragma unroll
                for (int n = 0; n < 2; ++n)
#pragma unroll
                    for (int e = 0; e < 4; ++e) {
                        const float g = acc[ai][0][m][n][e], gp = (m > 0) ? acc[ai][0][m - 1][n][e] : 0.f;
                        const float r1a = dpp_ror1(g), r1b = dpp_ror1(gp), r2a = dpp_ror2(g), r2b = dpp_ror2(gp);
                        const float g1 = (fr == 0) ? r1b : r1a, g2 = (fr < 2) ? r2b : r2a;
                        const float a = cb[n][e] + w0[n][e] * g2 + w1[n][e] * g1 + w2[n][e] * g;
                        res[n][e] = a * sigmoidf_fast(a) * acc[ai][1][m][n][e];
                    }
                const int row = rb + m * 16 + fr;
                if (m == 0 && fr < 2) {
                    float* gd = gdef + (size_t)(blk * 2 + fr) * FF + f0; float* ud = udef + (size_t)(blk * 2 + fr) * FF + f0;
                    *(f32x4*)gd = acc[ai][0][0][0]; *(f32x4*)(gd + 4) = acc[ai][0][0][1]; *(f32x4*)ud = acc[ai][1][0][0]; *(f32x4*)(ud + 4) = acc[ai][1][0][1];
                } else {
                    *(u32x4*)(act + (size_t)row * FF + f0) = pack8(res[0], res[1]);
                }
                if (m == 3 && fr >= 14) { float* gh = ghalo + (size_t)(blk * 2 + (fr - 14)) * FF + f0; *(f32x4*)gh = acc[ai][0][3][0]; *(f32x4*)(gh + 4) = acc[ai][0][3][1]; }
            }
        }
    }
};

template <class Epi, class Sched, bool ALIGN_EPI = false, bool SP2 = false, bool FP8 = false, bool I8 = false>
__device__ __forceinline__ void gemm_phase(PG8_LAS unsigned char* lds, const Gemm g, const Sched& S, const Epi& E, const int tid, PG8_LAS unsigned long long* tstat = nullptr) {
#ifdef PROBE_GEMM_TIME
    const unsigned long long tph0_ = clock64();
#endif
    const int wid = __builtin_amdgcn_readfirstlane(tid >> 6), lane = tid & 63, wr = wid >> 2, wc = wid & 3, fr = lane & 15, fq = lane >> 4;
    const int K = g.K, nt = K / BK;
    unsigned voffA[2], voffB[2];
#pragma unroll
    for (int i = 0; i < 2; ++i) { int R, C; stage_rc(tid * 16 + i * 8192, R, C); const int Rb = Epi::PERM ? ((R & ~31) + perm32(R & 31)) : R;
        voffA[i] = (unsigned)(R * K + C) * 2u; voffB[i] = (unsigned)(Rb * K + C) * 2u; }
    const size_t rstep64 = (size_t)64 * K * 2;
    const size_t kstep = (size_t)(BK * 2);
    const size_t hstep = (size_t)HALF * K * 2;
    const size_t tstep = 2 * hstep;
    const unsigned ldsw = (unsigned)wid * 1024u;
    const int aoff = lds_byte(wr * 64 + fr, fq * 8), boff = lds_byte(wc * 32 + fr, fq * 8);
#define PG8_SA(b, h) (((b) * 2 + (h)) * HTB)
#define PG8_PA(u) ((const char*)((u).part ? g.A2 : g.A) + (size_t)(u).pm * tstep)
#define PG8_PB(u) ((const char*)((u).part ? g.Bt2 : g.Bt) + (size_t)(u).pn * tstep)
#define PG8_SB(b, h) ((4 + (b) * 2 + (h)) * HTB)
#define PG8_STAGE(bufoff, gbase, voff) do { _Pragma("unroll") for (int _i = 0; _i < 2; ++_i)   \
        __builtin_amdgcn_global_load_lds((const unsigned*)((const char*)(gbase) + (size_t)_i * rstep64 + (voff)[0]), (PG8_LAS unsigned*)(lds + (bufoff) + ldsw + _i * 8192), 16, 0, 0); } while (0)
#define PG8_LDA(dst, b, h) do { _Pragma("unroll") for (int m = 0; m < 4; ++m) _Pragma("unroll") for (int k = 0; k < 2; ++k) dst[m][k] = *(const PG8_LAS bf16x8*)(lds + PG8_SA(b, h) + aoff + m * 2048 + k * 1024); } while (0)
#define PG8_LDB(dst, b, h) do { _Pragma("unroll") for (int n = 0; n < 2; ++n) _Pragma("unroll") for (int k = 0; k < 2; ++k) dst[n][k] = *(const PG8_LAS bf16x8*)(lds + PG8_SB(b, h) + boff + n * 2048 + k * 1024); } while (0)
#define PG8_MMA(ai, bj, At, Bt) do { __builtin_amdgcn_s_setprio(1); \
        if constexpr (FP8) { _Pragma("unroll") for (int m = 0; m < 4; ++m) _Pragma("unroll") for (int n = 0; n < 2; ++n) { \
            const u32x4 b0_ = __builtin_bit_cast(u32x4, Bt[n][0]), b1_ = __builtin_bit_cast(u32x4, Bt[n][1]), a0_ = __builtin_bit_cast(u32x4, At[m][0]), a1_ = __builtin_bit_cast(u32x4, At[m][1]); \
            const i32x8 bo_ = {(int)b0_.x, (int)b0_.y, (int)b0_.z, (int)b0_.w, (int)b1_.x, (int)b1_.y, (int)b1_.z, (int)b1_.w}, ao_ = {(int)a0_.x, (int)a0_.y, (int)a0_.z, (int)a0_.w, (int)a1_.x, (int)a1_.y, (int)a1_.z, (int)a1_.w}; \
            acc[ai][bj][m][n] = __builtin_amdgcn_mfma_scale_f32_16x16x128_f8f6f4(bo_, ao_, acc[ai][bj][m][n], 0, 0, 0, 0x7f7f7f7f, 0, 0x7f7f7f7f); } } \
        else if constexpr (I8) {   \
            _Pragma("unroll") for (int m = 0; m < 4; ++m) _Pragma("unroll") for (int n = 0; n < 2; ++n) _Pragma("unroll") for (int k = 0; k < 2; ++k) \
            acc[ai][bj][m][n] = __builtin_bit_cast(f32x4, __builtin_amdgcn_mfma_i32_16x16x64_i8(__builtin_bit_cast(i32x4q, Bt[n][k]), __builtin_bit_cast(i32x4q, At[m][k]), __builtin_bit_cast(i32x4q, acc[ai][bj][m][n]), 0, 0, 0)); } \
        else { _Pragma("unroll") for (int m = 0; m < 4; ++m) _Pragma("unroll") for (int n = 0; n < 2; ++n) _Pragma("unroll") for (int k = 0; k < 2; ++k) \
            acc[ai][bj][m][n] = __builtin_amdgcn_mfma_f32_16x16x32_f16(__builtin_bit_cast(h16x8, Bt[n][k]), __builtin_bit_cast(h16x8, At[m][k]), acc[ai][bj][m][n], 0, 0, 0); } \
        __builtin_amdgcn_s_setprio(0); } while (0)
#define PG8_WAIT_V(n) asm volatile("s_waitcnt vmcnt(" #n ")" ::: "memory")
#define PG8_WAIT_L(n) asm volatile("s_waitcnt lgkmcnt(" #n ")" ::: "memory")
#define PG8_BAR __builtin_amdgcn_s_barrier()
#define PG8_SCHED __builtin_amdgcn_sched_barrier(0)
    Unit cur, nxt; int ui = 0;
    if (!S.next(0, cur)) return;
    f32x4 acc[2][2][4][2];
#pragma unroll
    for (int a = 0; a < 2; ++a)
#pragma unroll
        for (int b = 0; b < 2; ++b)
#pragma unroll
            for (int m = 0; m < 4; ++m)
#pragma unroll
                for (int n = 0; n < 2; ++n) acc[a][b][m][n] = (f32x4){0.f, 0.f, 0.f, 0.f};
    bf16x8 At[4][2], B0[2][2], B1[2][2];
    const char* cA = PG8_PA(cur); const char* cB = PG8_PB(cur);
    if constexpr (SP2) {
        PG8_STAGE(PG8_SB(0, 0), cB, voffB); PG8_STAGE(PG8_SB(0, 1), cB + hstep, voffB); PG8_STAGE(PG8_SA(0, 0), cA, voffA); PG8_STAGE(PG8_SA(0, 1), cA + hstep, voffA);
        if (wr == 1) PG8_BAR;
        PG8_WAIT_V(2); PG8_BAR;
        PG8_STAGE(PG8_SB(1, 0), cB + kstep, voffB); PG8_STAGE(PG8_SA(1, 0), cA + kstep, voffA); PG8_STAGE(PG8_SB(1, 1), cB + hstep + kstep, voffB);
        PG8_WAIT_V(6); PG8_BAR;
    } else {
        PG8_STAGE(PG8_SB(0, 0), cB, voffB); PG8_STAGE(PG8_SA(0, 0), cA, voffA); PG8_STAGE(PG8_SB(0, 1), cB + hstep, voffB); PG8_STAGE(PG8_SA(0, 1), cA + hstep, voffA);
        if (wr == 1) PG8_BAR;
        PG8_WAIT_V(4); PG8_BAR;
        PG8_STAGE(PG8_SB(1, 0), cB + kstep, voffB); PG8_STAGE(PG8_SA(1, 0), cA + kstep, voffA); PG8_STAGE(PG8_SB(1, 1), cB + hstep + kstep, voffB);
        PG8_WAIT_V(6); PG8_BAR;
    }
    for (;;) {
        const bool has_next = S.next(ui + 1, nxt);
        const char* nA = has_next ? PG8_PA(nxt) : cA; const char* nB = has_next ? PG8_PB(nxt) : cB;
        for (int t = 0; t < nt; t += 2) {
            const bool last = (t == nt - 2);
            const char* a1 = cA + (size_t)(t + 1) * kstep;
            const char* a2 = last ? nA : cA + (size_t)(t + 2) * kstep; const char* b2 = last ? nB : cB + (size_t)(t + 2) * kstep;
            const char* a3 = a2 + kstep; const char* b3 = b2 + kstep;
            if constexpr (SP2) {
            PG8_LDB(B0, 0, 0); PG8_LDB(B1, 0, 1); PG8_SCHED; PG8_LDA(At, 0, 0); PG8_STAGE(PG8_SA(1, 1), a1 + hstep, voffA);
            PG8_WAIT_V(8); PG8_WAIT_L(0); PG8_BAR; PG8_MMA(0, 0, At, B0); PG8_MMA(0, 1, At, B1); PG8_BAR; PG8_SCHED;
            PG8_LDA(At, 0, 1); PG8_STAGE(PG8_SB(0, 0), b2, voffB); PG8_STAGE(PG8_SB(0, 1), b2 + hstep, voffB); PG8_STAGE(PG8_SA(0, 0), a2, voffA);
            PG8_WAIT_V(8); PG8_WAIT_L(0); PG8_BAR; PG8_MMA(1, 0, At, B0); PG8_MMA(1, 1, At, B1); PG8_BAR; PG8_SCHED;
            PG8_LDB(B0, 1, 0); PG8_LDB(B1, 1, 1); PG8_SCHED; PG8_LDA(At, 1, 0); PG8_STAGE(PG8_SA(0, 1), a2 + hstep, voffA);
            PG8_WAIT_V(8); PG8_WAIT_L(0); PG8_BAR; PG8_MMA(0, 0, At, B0); PG8_MMA(0, 1, At, B1); PG8_BAR; PG8_SCHED;
            PG8_LDA(At, 1, 1); PG8_STAGE(PG8_SB(1, 0), b3, voffB); PG8_STAGE(PG8_SB(1, 1), b3 + hstep, voffB); PG8_STAGE(PG8_SA(1, 0), a3, voffA);
            PG8_WAIT_V(8); PG8_WAIT_L(0); PG8_BAR; PG8_MMA(1, 0, At, B0); PG8_MMA(1, 1, At, B1); PG8_BAR; PG8_SCHED;
            } else {
            PG8_LDB(B0, 0, 0); PG8_SCHED; PG8_LDA(At, 0, 0); PG8_STAGE(PG8_SA(1, 1), a1 + hstep, voffA);
            PG8_WAIT_L(8); PG8_BAR; PG8_WAIT_L(0); PG8_MMA(0, 0, At, B0); PG8_BAR; PG8_SCHED;
            PG8_LDB(B1, 0, 1); PG8_STAGE(PG8_SB(0, 0), b2, voffB);
            PG8_BAR; PG8_WAIT_L(0); PG8_MMA(0, 1, At, B1); PG8_BAR;
            PG8_LDA(At, 0, 1); PG8_STAGE(PG8_SA(0, 0), a2, voffA);
            PG8_BAR; PG8_WAIT_L(0); PG8_MMA(1, 0, At, B0); PG8_BAR; PG8_SCHED;
            PG8_STAGE(PG8_SB(0, 1), b2 + hstep, voffB);
            PG8_WAIT_V(6); PG8_BAR; PG8_MMA(1, 1, At, B1); PG8_BAR;
            PG8_LDB(B0, 1, 0); PG8_SCHED; PG8_LDA(At, 1, 0); PG8_STAGE(PG8_SA(0, 1), a2 + hstep, voffA);
            PG8_WAIT_L(8); PG8_BAR; PG8_WAIT_L(0); PG8_MMA(0, 0, At, B0); PG8_BAR; PG8_SCHED;
            PG8_LDB(B1, 1, 1); PG8_STAGE(PG8_SB(1, 0), b3, voffB);
            PG8_BAR; PG8_WAIT_L(0); PG8_MMA(0, 1, At, B1); PG8_BAR;
            PG8_LDA(At, 1, 1); PG8_STAGE(PG8_SA(1, 0), a3, voffA);
            PG8_BAR; PG8_WAIT_L(0); PG8_MMA(1, 0, At, B0); PG8_BAR; PG8_SCHED;
            PG8_STAGE(PG8_SB(1, 1), b3 + hstep, voffB);
            PG8_WAIT_V(6); PG8_BAR; PG8_MMA(1, 1, At, B1); PG8_BAR;
            }
        }
        if constexpr (ALIGN_EPI) { if (wr == 0) PG8_BAR; }

#ifdef PROBE_GEMM_TIME
        { const unsigned long long te0_ = clock64(); E(acc, cur, wr, wc, fr, fq); asm volatile("s_waitcnt vmcnt(0)" ::: "memory"); if (tstat && tid == 0) { tstat[0] += clock64() - te0_; } }
#else
        if constexpr (FP8) { int l_; asm volatile("v_mbcnt_lo_u32_b32 %0, -1, 0\n\tv_mbcnt_hi_u32_b32 %0, -1, %0" : "=v"(l_)); E(acc, cur, wr, wc, l_ & 15, l_ >> 4); }
        else E(acc, cur, wr, wc, fr, fq);
#endif
        if (!has_next) break;
        if (!E.keep(cur))
#pragma unroll
        for (int a = 0; a < 2; ++a)
#pragma unroll
            for (int b = 0; b < 2; ++b)
#pragma unroll
                for (int m = 0; m < 4; ++m)
#pragma unroll
                    for (int n = 0; n < 2; ++n) acc[a][b][m][n] = (f32x4){0.f, 0.f, 0.f, 0.f};
        cur = nxt; cA = nA; cB = nB; ++ui;
        if constexpr (ALIGN_EPI) { if (wr == 1) PG8_BAR; }
    }
    PG8_WAIT_V(0);
    if constexpr (!ALIGN_EPI) { if (wr == 0) PG8_BAR; }
    PG8_BAR;
#ifdef PROBE_GEMM_TIME
    if (tstat && tid == 0) tstat[1] += clock64() - tph0_;
#endif
#undef PG8_SA
#undef PG8_PA
#undef PG8_PB
#undef PG8_SB
#undef PG8_STAGE
#undef PG8_LDA
#undef PG8_LDB
#undef PG8_MMA
#undef PG8_WAIT_V
#undef PG8_WAIT_L
#undef PG8_BAR
#undef PG8_SCHED
}
}


constexpr int BATCH = 2, SEQ = 8192, DM = 2048, MROWS = BATCH * SEQ;
constexpr int HD = 128, NHEAD = 8, WATT = NHEAD * HD;
constexpr int NIH = 16, IDIM = 64, TOPK = 256;
constexpr int FF = 5632, P_IN = 11344, N_IN_PAD = 11520;
constexpr float EPS = 1e-6f, LOG2E = 1.4426950408889634f;
constexpr float QK_SCALE = 0.08838834764831845f;
constexpr int NPH = 12;
constexpr int N_LAUNCHES = MK_N_LAUNCHES;
constexpr int NWAVES = 8;

constexpr size_t MiB = 1u << 20;
constexpr size_t WS_CTL = 0, WS_BM = 1 * MiB, ZERO_BYTES = 1 * MiB;
constexpr size_t WS_MOD = 17 * MiB;
constexpr size_t WS_WIN = 18 * MiB;
constexpr size_t WS_WOSB = 63 * MiB, WS_WODS = 67 * MiB, WS_WOUT = 71 * MiB;
constexpr size_t WS_WGU = 79 * MiB;
constexpr size_t WS_WDN = 123 * MiB;
constexpr size_t WS_H = 145 * MiB;
constexpr size_t WS_SEG = 209 * MiB, SEG_BYTES = 32 * MiB;
constexpr size_t WS_KIX = 433 * MiB, WS_WIX = 435 * MiB, WS_D1 = 436 * MiB, WS_END = 500 * MiB;
constexpr size_t WS_ACT = WS_SEG;
constexpr size_t HALO_BYTES = (size_t)512 * FF * 4;
constexpr size_t WS_GHALO = WS_WIN, WS_GDEF = WS_WIN + 12 * MiB, WS_UDEF = WS_WIN + 24 * MiB;
static_assert(WS_WIN + (size_t)N_IN_PAD * DM * 2 <= WS_WOSB && WS_WGU + (size_t)2 * FF * DM * 2 <= WS_WDN && WS_WDN + (size_t)DM * FF * 2 <= WS_H && WS_H + (size_t)MROWS * DM * 2 <= WS_SEG, "ws map");
static_assert(WS_SEG + 7 * SEG_BYTES <= WS_KIX && WS_ACT + (size_t)MROWS * FF * 2 <= WS_KIX && HALO_BYTES <= 12 * MiB && WS_UDEF + HALO_BYTES <= WS_WOSB, "ws map 2");
constexpr float WGU_QS = 127.0f * 45.254834f / 4.5f;
constexpr size_t WS_SA1 = WS_MOD + 256 * 1024;
constexpr size_t WS_SA = WS_MOD + 512 * 1024;
constexpr float H8_SCALE = 8.0f, W8_SCALE = 64.0f;
constexpr size_t WS_WG8 = WS_WIN + (size_t)7168 * DM * 2;
constexpr size_t OUT_H8 = (size_t)64 * MiB;
constexpr int CW_BAR = 4096;

constexpr int RING_OFF = 0, RING_BYTES = 131072;
constexpr int LDSCTL_OFF = RING_BYTES, MISC_OFF = LDSCTL_OFF + 320;
constexpr int EXTRA_OFF = 131584;
constexpr int LDS_BYTES = 147456;

#define GAS __attribute__((address_space(1)))
#define LAS __attribute__((address_space(3)))
typedef unsigned short bf16;
typedef float f32x4 __attribute__((ext_vector_type(4)));
typedef float f32x16 __attribute__((ext_vector_type(16)));
typedef short bf16x8 __attribute__((ext_vector_type(8)));
typedef short s16x4 __attribute__((ext_vector_type(4)));
typedef unsigned u32x4 __attribute__((ext_vector_type(4)));
typedef unsigned u32x2 __attribute__((ext_vector_type(2)));
typedef unsigned short u16x2 __attribute__((ext_vector_type(2)));
typedef unsigned long long u64;
typedef GAS unsigned gu32;
#define LDS_WAIT() asm volatile("s_waitcnt lgkmcnt(0)" ::: "memory")
#define VM_WAIT() asm volatile("s_waitcnt vmcnt(0)" ::: "memory")
#define SBAR() __builtin_amdgcn_sched_barrier(0)
#define XB_TMO      128
#define XB_XCNT(j)  (256  + 64 * (j))
#define XB_XSUB(j)  (1280 + 64 * (j))
#define XB_XGEN(j)  (2304 + 64 * (j))
#define XB_TOP      3328
#define XB_TOPGEN   3392
#define XCD_BAR_WORDS 3456
#define XB_SPIN_CAP (1u << 18)

__device__ __forceinline__ unsigned xb_ld(unsigned* p)              { return __hip_atomic_load(p, __ATOMIC_RELAXED, __HIP_MEMORY_SCOPE_AGENT); }
__device__ __forceinline__ unsigned xb_add(unsigned* p, unsigned v) { return __hip_atomic_fetch_add(p, v, __ATOMIC_RELAXED, __HIP_MEMORY_SCOPE_AGENT); }
__device__ __forceinline__ unsigned xb_xcc_id() { return (unsigned)__builtin_amdgcn_s_getreg((3 << 11) | 20) & 0xFu; }
#define XB_SPIN(cond, bar) do { unsigned _sp = 0; while (cond) { __builtin_amdgcn_s_sleep(1); \
    if ((++_sp & 255u) == 0u) { if (xb_ld(&(bar)[XB_TMO])) break; if (_sp > XB_SPIN_CAP) { atomicAdd(&(bar)[XB_TMO], 1u); break; } } } } while (0)

struct XcdBarrier {
    unsigned* bar; unsigned x;
    volatile LAS unsigned* st;
};

__device__ __forceinline__ XcdBarrier xcd_barrier_post(unsigned* bar, volatile LAS unsigned* st, const bool thread0  ) {
    XcdBarrier b; b.bar = bar; b.x = xb_xcc_id(); b.st = st;
    if (thread0) (void)xb_add(&bar[XB_XCNT(b.x)], 1u);
    return b;
}
__device__ __forceinline__ void xcd_barrier_complete(unsigned* bar, unsigned x, unsigned& nloc, unsigned& nx) {
    const unsigned G = gridDim.x * gridDim.y * gridDim.z;
    unsigned sum, cnt, mine, sp = 0u;
    for (;;) {
        sum = 0u; cnt = 0u; mine = 0u;
#pragma unroll
        for (unsigned j = 0; j < 16; ++j) { const unsigned c = xb_ld(&bar[XB_XCNT(j)]); sum += c; cnt += (c > 0u) ? 1u : 0u; mine = (j == x) ? c : mine; }
        if (sum == G) break;
        __builtin_amdgcn_s_sleep(1);
        if ((++sp & 255u) == 0u) { if (xb_ld(&bar[XB_TMO])) break; if (sp > XB_SPIN_CAP) { atomicAdd(&bar[XB_TMO], 1u); break; } }
    }
    nloc = mine > 0u ? mine : 1u; nx = cnt > 0u ? cnt : 1u;
}

__device__ __forceinline__ void xcd_barrier(const XcdBarrier& b, const bool thread0  ) {
    asm volatile("s_waitcnt vmcnt(0)" ::: "memory");
    __syncthreads();
    if (thread0) {
        unsigned* bar = b.bar;
        __builtin_amdgcn_s_waitcnt(0);
        unsigned nloc = b.st[0], nx = b.st[1];
        if (nloc == 0u) { xcd_barrier_complete(bar, b.x, nloc, nx); b.st[0] = nloc; b.st[1] = nx; }
        const unsigned old = xb_add(&bar[XB_XSUB(b.x)], 1u);
        const unsigned gen = old / nloc;
        if (old + 1u == (gen + 1u) * nloc) {
            __builtin_amdgcn_fence(__ATOMIC_RELEASE, "agent");
            asm volatile("s_waitcnt vmcnt(0)" ::: "memory");
            const unsigned og = xb_add(&bar[XB_TOP], 1u);
            const unsigned tg = og / nx;
            if (og + 1u == (tg + 1u) * nx) xb_add(&bar[XB_TOPGEN], 1u);
            else XB_SPIN(xb_ld(&bar[XB_TOPGEN]) == tg, bar);
            __builtin_amdgcn_fence(__ATOMIC_ACQUIRE, "agent");
            xb_add(&bar[XB_XGEN(b.x)], 1u);
            asm volatile("s_waitcnt vmcnt(0)" ::: "memory");
        } else {
            XB_SPIN(xb_ld(&bar[XB_XGEN(b.x)]) == gen, bar);
            __builtin_amdgcn_fence(__ATOMIC_ACQUIRE, "agent");
            asm volatile("s_waitcnt vmcnt(0)" ::: "memory");
        }
    }
    __syncthreads();
}

struct Frame {
    LAS unsigned char* lds;
    volatile LAS unsigned* MISC;
    int tid, lane, wave;
    int vcu, G;
};
__device__ __forceinline__ float wave_sum(float v) {
#pragma unroll
    for (int o = 1; o < 64; o <<= 1) v += __shfl_xor(v, o);
    return v;
}
__device__ __forceinline__ int wave_sum_i(int v) {
#pragma unroll
    for (int o = 1; o < 64; o <<= 1) v += __shfl_xor(v, o);
    return v;
}
__device__ __forceinline__ unsigned pk2(float lo, float hi) { return pg8::cvt_pk_bf16(lo, hi); }
__device__ __forceinline__ unsigned cvtpk(float lo, float hi) { return pg8::cvt_pk_bf16(lo, hi); }


__device__ __forceinline__ f32x16 MFMA32(bf16x8 a, bf16x8 b, f32x16 c) { return __builtin_amdgcn_mfma_f32_32x32x16_f16(__builtin_bit_cast(pg8::h16x8, a), __builtin_bit_cast(pg8::h16x8, b), c, 0, 0, 0); }
__device__ __forceinline__ void ph0_mod(const Frame& F, const float* c, const float* w_ada, const float* b_ada, float* mod) {
    LAS float* sc = (LAS float*)(F.lds);
    LAS float* part = (LAS float*)(F.lds + 16384);
    for (int i = F.tid; i < 2 * DM; i += NWAVES * 64) { const float v = c[i]; sc[i] = v / (1.f + __expf(-v)); }
    __syncthreads();
    for (int cg = F.vcu; cg < 256; cg += F.G) {
        const int c4 = F.tid % 12, dr = F.tid / 12;
        if (dr < 42) {
            f32x4 a0 = {0.f, 0.f, 0.f, 0.f}, a1 = {0.f, 0.f, 0.f, 0.f};
            const float* wp = w_ada + (size_t)48 * cg + 4 * c4;
#pragma unroll 8
            for (int d = dr; d < DM; d += 42) { const f32x4 w = *(const f32x4*)(wp + (size_t)d * (6 * DM)); a0 += sc[d] * w; a1 += sc[DM + d] * w; }
#pragma unroll
            for (int e = 0; e < 4; ++e) { part[dr * 96 + 4 * c4 + e] = a0[e]; part[dr * 96 + 48 + 4 * c4 + e] = a1[e]; }
        }
        __syncthreads();
        if (F.tid < 96) { float s = 0.f; for (int r = 0; r < 42; ++r) s += part[r * 96 + F.tid]; const int b = F.tid / 48, col = F.tid % 48; mod[b * (6 * DM) + 48 * cg + col] = s + b_ada[48 * cg + col]; }
        __syncthreads();
    }
}
template <int MODE> __device__ __forceinline__ int row_map(int n, int off) {
    if (MODE == 0) return off + n;
    if (MODE == 1) return n < 2048 ? n : (n < 7168 ? n - 4096   : (n < 7248 ? 11264 + (n - 7168) : 7168 + (n - 7248)));
    if (MODE == 2) return (n >> 7) * 256 + (n & 127);
    return (n >> 7) * 256 + 128 + (n & 127);
}
template <int MODE> __device__ __forceinline__ void tr_item(const float* W, int K, int N, bf16* WT, int off, LAS float* scr, int item, int lane) {
    const int nblk = (N + 31) / 32, kb = item / nblk, nb = item % nblk, k0 = 64 * kb, n0 = 32 * nb;
    const bool cok = (n0 + (lane & 31)) < N;
    float tv[32];
#pragma unroll
    for (int i = 0; i < 32; ++i) { const int kk = 2 * i + (lane >> 5); tv[i] = cok ? W[(size_t)(k0 + kk) * N + n0 + (lane & 31)] : 0.f; }
#pragma unroll
    for (int i = 0; i < 32; ++i) { const int kk = 2 * i + (lane >> 5); scr[kk * 33 + (lane & 31)] = tv[i]; }
    LDS_WAIT(); asm volatile("" ::: "memory");
    const int c = lane & 7;
#pragma unroll
    for (int j = 0; j < 4; ++j) { const int n = (lane >> 3) + 8 * j; const LAS float* s = scr + (8 * c) * 33 + n;
        u32x4 o; o.x = pk2(s[0 * 33], s[1 * 33]); o.y = pk2(s[2 * 33], s[3 * 33]); o.z = pk2(s[4 * 33], s[5 * 33]); o.w = pk2(s[6 * 33], s[7 * 33]);
        if (MODE == 1 && (n0 + n >= 7248 || (n0 + n >= 2048 && n0 + n < 6144))) {
            const int r8 = (n0 + n >= 7248) ? (n0 + n - 7248) : (4096 + n0 + n - 2048);
            if (n0 + n < N) { unsigned a = 0u, b = 0u;
#pragma unroll
                for (int e = 0; e < 4; ++e) { int qa = (int)rintf(s[e * 33] * WGU_QS), qb = (int)rintf(s[(4 + e) * 33] * WGU_QS); qa = qa < -127 ? -127 : (qa > 127 ? 127 : qa); qb = qb < -127 ? -127 : (qb > 127 ? 127 : qb);
                    a |= ((unsigned)qa & 0xffu) << (8 * e); b |= ((unsigned)qb & 0xffu) << (8 * e); }
                u32x2 o8; o8.x = a; o8.y = b; *(GAS u32x2*)((unsigned char*)WT + (size_t)7168 * K * 2 + (size_t)r8 * K + k0 + 8 * c) = o8; } }
        else if (MODE == 2 || MODE == 3) {
            if (n0 + n < N) { unsigned lo = 0u, hi = 0u;
#pragma unroll
                for (int e = 0; e < 4; ++e) { int qa = (int)rintf(s[e * 33] * WGU_QS), qb = (int)rintf(s[(4 + e) * 33] * WGU_QS); qa = qa < -127 ? -127 : (qa > 127 ? 127 : qa); qb = qb < -127 ? -127 : (qb > 127 ? 127 : qb);
                    lo |= ((unsigned)qa & 0xffu) << (8 * e); hi |= ((unsigned)qb & 0xffu) << (8 * e); }
                u32x2 o8; o8.x = lo; o8.y = hi; *(GAS u32x2*)((unsigned char*)WT + (size_t)row_map<MODE>(n0 + n, off) * K + k0 + 8 * c) = o8; } }
        else if (n0 + n < N) *(GAS u32x4*)(WT + (size_t)row_map<MODE>(n0 + n, off) * K + k0 + 8 * c) = o; }
    LDS_WAIT(); asm volatile("" ::: "memory");
}
struct WPtrs { const float *w_in, *w_osb, *w_ods, *w_out, *w_gate, *w_up, *w_down; bf16 *t_in, *t_osb, *t_ods, *t_out, *t_gu, *t_dn; };
__device__ __forceinline__ void ph0_weights(const Frame& F, const WPtrs& P, int part, int wg, int nwg) {
    LAS float* scr = (LAS float*)(F.lds + RING_OFF + F.wave * 16384);
    const int gw = wg * NWAVES + F.wave, NGW = nwg * NWAVES;
    constexpr int I_IN = (DM / 64) * ((P_IN + 31) / 32), I_O = (WATT / 64) * (DM / 32), I_OUT = (DM / 64) * (DM / 32), I_G = (DM / 64) * (FF / 32), I_D = (FF / 64) * (DM / 32);
    if (part == 0) {
        for (int it = gw; it < I_IN; it += NGW) tr_item<1>(P.w_in, DM, P_IN, P.t_in, 0, scr, it, F.lane);
        GAS u32x4* z = (GAS u32x4*)(P.t_in + (size_t)P_IN * DM); const int n16 = (N_IN_PAD - P_IN) * DM * 2 / 16;
        for (int i = wg * (NWAVES * 64) + F.tid; i < n16; i += nwg * NWAVES * 64) z[i] = (u32x4){0u, 0u, 0u, 0u};
    } else {
        constexpr int NITEMS = 2 * I_O + I_OUT + 2 * I_G + I_D;
        for (int it = gw; it < NITEMS; it += NGW) {
            int r = it;
            if (r < I_O) { tr_item<0>(P.w_osb, WATT, DM, P.t_osb, 0, scr, r, F.lane); continue; } r -= I_O;
            if (r < I_O) { tr_item<0>(P.w_ods, WATT, DM, P.t_ods, 0, scr, r, F.lane); continue; } r -= I_O;
            if (r < I_OUT) { tr_item<0>(P.w_out, DM, DM, P.t_out, 0, scr, r, F.lane); continue; } r -= I_OUT;
            if (r < I_G) { tr_item<2>(P.w_gate, DM, FF, P.t_gu, 0, scr, r, F.lane); continue; } r -= I_G;
            if (r < I_G) { tr_item<3>(P.w_up, DM, FF, P.t_gu, 0, scr, r, F.lane); continue; } r -= I_G;
            tr_item<0>(P.w_down, FF, DM, P.t_dn, 0, scr, r, F.lane);
        }
    }
}

template <int MODE> __device__ __forceinline__ void norm_mod_rows(const Frame& F, const void* X, bf16* C, bf16* H, unsigned char* Q8, float* SA, const float* g, const float* shift, const float* scale) {
    const int gw = F.vcu * NWAVES + F.wave, NGW = F.G * NWAVES;
    for (int rb = gw; rb < MROWS / 8; rb += NGW) {
        const int b = (rb * 8) / SEQ;
        f32x4 gs[8], sh[8];
#pragma unroll
        for (int j = 0; j < 8; ++j) { const int col = 4 * (64 * j + F.lane); gs[j] = *(const f32x4*)(g + col) * (1.0f + *(const f32x4*)(scale + (size_t)b * 6 * DM + col)); sh[j] = *(const f32x4*)(shift + (size_t)b * 6 * DM + col); }
        for (int rr = 0; rr < 8; ++rr) {
            const size_t row = (size_t)rb * 8 + rr;
            f32x4 v[8]; float s = 0.f;
            if (MODE == 0) { const GAS f32x4* xr = (const GAS f32x4*)((const float*)X + row * DM) + F.lane;
#pragma unroll
                for (int j = 0; j < 8; ++j) v[j] = xr[64 * j];
                GAS u32x2* xo = (GAS u32x2*)(C + row * DM) + F.lane;
#pragma unroll
                for (int j = 0; j < 8; ++j) { u32x2 w; w.x = cvtpk(v[j].x, v[j].y); w.y = cvtpk(v[j].z, v[j].w); xo[64 * j] = w; } }
            else { const GAS u32x2* dr = (const GAS u32x2*)((const bf16*)X + row * DM) + F.lane; u32x2 hv[8];
#pragma unroll
                for (int j = 0; j < 8; ++j) hv[j] = dr[64 * j];
#pragma unroll
                for (int j = 0; j < 8; ++j) v[j] = (f32x4){pg8::bf_lo(hv[j].x), pg8::bf_hi(hv[j].x), pg8::bf_lo(hv[j].y), pg8::bf_hi(hv[j].y)}; }
#pragma unroll
            for (int j = 0; j < 8; ++j) s += (v[j].x * v[j].x + v[j].y * v[j].y) + (v[j].z * v[j].z + v[j].w * v[j].w);
            const float rs = 1.0f / sqrtf(wave_sum(s) * (1.0f / DM) + EPS);
            f32x4 y[8]; float mx = 0.f;
#pragma unroll
            for (int j = 0; j < 8; ++j) { y[j] = v[j] * rs * gs[j] + sh[j]; mx = fmaxf(mx, fmaxf(fmaxf(fabsf(y[j].x), fabsf(y[j].y)), fmaxf(fabsf(y[j].z), fabsf(y[j].w)))); }
            if (MODE == 0) { GAS u32x2* o8 = (GAS u32x2*)(H + row * DM) + F.lane;
#pragma unroll
                for (int j = 0; j < 8; ++j) { u32x2 w; w.x = cvtpk(y[j].x, y[j].y); w.y = cvtpk(y[j].z, y[j].w); o8[64 * j] = w; } }
#pragma unroll
            for (int o = 1; o < 64; o <<= 1) mx = fmaxf(mx, __shfl_xor(mx, o));
            mx = fmaxf(mx, 1e-20f);
            const float inv = 127.0f / mx;
            GAS unsigned* oq = (GAS unsigned*)((MODE == 0 ? Q8 : (unsigned char*)H) + row * DM) + F.lane;
#pragma unroll
            for (int j = 0; j < 8; ++j) { const int q0 = (int)rintf(y[j].x * inv), q1 = (int)rintf(y[j].y * inv), q2 = (int)rintf(y[j].z * inv), q3 = (int)rintf(y[j].w * inv);
                oq[64 * j] = ((unsigned)q0 & 0xffu) | (((unsigned)q1 & 0xffu) << 8) | (((unsigned)q2 & 0xffu) << 16) | ((unsigned)q3 << 24); }
            if (F.lane == 0) SA[row] = mx * (1.0f / (127.0f * WGU_QS));
        }
    }
}
__device__ __forceinline__ void norm_final_rows(const Frame& F, const bf16* X1, const bf16* D2, float* O, const float* g) {
    const int gw = F.vcu * NWAVES + F.wave, NGW = F.G * NWAVES;
    f32x4 gs[8];
#pragma unroll
    for (int j = 0; j < 8; ++j) gs[j] = *(const f32x4*)(g + 4 * (64 * j + F.lane));
    for (int row = gw; row < MROWS; row += NGW) {
        GAS f32x4* orow = (GAS f32x4*)(O + (size_t)row * DM) + F.lane;
        const GAS u32x2* d1 = (const GAS u32x2*)(X1 + (size_t)row * DM) + F.lane; const GAS u32x2* d2 = (const GAS u32x2*)(D2 + (size_t)row * DM) + F.lane;
        f32x4 v[8]; u32x2 h1[8], h2[8]; float s = 0.f;
#pragma unroll
        for (int j = 0; j < 8; ++j) { h1[j] = d1[64 * j]; h2[j] = d2[64 * j]; }
#pragma unroll
        for (int j = 0; j < 8; ++j) { v[j] = (f32x4){pg8::bf_lo(h1[j].x), pg8::bf_hi(h1[j].x), pg8::bf_lo(h1[j].y), pg8::bf_hi(h1[j].y)} + (f32x4){pg8::bf_lo(h2[j].x), pg8::bf_hi(h2[j].x), pg8::bf_lo(h2[j].y), pg8::bf_hi(h2[j].y)};
            s += (v[j].x * v[j].x + v[j].y * v[j].y) + (v[j].z * v[j].z + v[j].w * v[j].w); }
        const float rs = 1.0f / sqrtf(wave_sum(s) * (1.0f / DM) + EPS);
#pragma unroll
        for (int j = 0; j < 8; ++j) orow[64 * j] = v[j] * rs * gs[j];
    }
}

namespace att {
constexpr int PITCH = WATT;
constexpr int SHM_T = 16384;
constexpr int OFF_V = 0, OFF_K = 3 * SHM_T, OFF_WS = 5 * SHM_T, OFF_TAB = OFF_WS + 2048, OFF_FLAG = OFF_TAB + 512;
#define KSWZ(row, colB) ((row) * 256 + ((colB) ^ (((row) & 7) << 4)))
__device__ __forceinline__ int v_st(int k, int c) { const int kk = (k & ~0xC) | ((k & 4) << 1) | ((k & 8) >> 1); return ((kk >> 3) * 4 + (c >> 5)) * 512 + ((kk & 7) * 32 + (c & 31)) * 2; }
__device__ __forceinline__ int v_rd_base(int lane) { return ((lane & 3) << 3) | (((lane >> 2) & 3) << 6) | (((lane >> 4) & 1) << 5) | (((lane >> 5) & 1) << 8); }
constexpr int v_rd_off(int d0, int ks, int half) { return d0 * 512 + ks * 4096 + half * 2048; }
__device__ __forceinline__ int crow(int r, int hi) { return (r & 3) + 8 * (r >> 2) + 4 * hi; }

__device__ __forceinline__ void qkt(f32x16& p0, f32x16& p1, const LAS char* Kb, int r32, int hi, const bf16x8* qr) {
    p0 = f32x16{}; p1 = f32x16{};
    const LAS char* kb[4];
#pragma unroll
    for (int dd = 0; dd < 4; ++dd) kb[dd] = Kb + KSWZ(r32, (dd * 16 + hi * 8) * 2);
#pragma unroll
    for (int d0 = 0; d0 < 8; ++d0) { const LAS char* a = kb[d0 & 3] + (d0 >> 2) * 128;
        const bf16x8 b0 = *(const LAS bf16x8*)a;
        const bf16x8 b1 = *(const LAS bf16x8*)(a + 32 * 256);
        p0 = MFMA32(b0, qr[d0], p0);
        p1 = MFMA32(b1, qr[d0], p1); }
}
__device__ __forceinline__ void pv_tile(f32x16* o, int vb0, bf16x8 pa0, bf16x8 pa1, bf16x8 pa2, bf16x8 pa3) {
#define TRRD(dst, off) asm volatile("ds_read_b64_tr_b16 %0, %1 offset:%2" : "=&v"(dst) : "v"(vb0), "i"(off) : "memory")
#define PV_D0(d0) do { s16x4 l0, l1, l2, l3, h0, h1, h2, h3; constexpr int b_ = v_rd_off(d0, 0, 0); \
        TRRD(l0, b_); TRRD(h0, b_ + 2048); TRRD(l1, b_ + 4096); TRRD(h1, b_ + 6144); TRRD(l2, b_ + 8192); TRRD(h2, b_ + 10240); TRRD(l3, b_ + 12288); TRRD(h3, b_ + 14336); \
        asm volatile("s_waitcnt lgkmcnt(0)" ::: "memory"); SBAR(); \
        o[d0] = MFMA32(pa0, (bf16x8){l0[0], l0[1], l0[2], l0[3], h0[0], h0[1], h0[2], h0[3]}, o[d0]);   \
        o[d0] = MFMA32(pa1, (bf16x8){l1[0], l1[1], l1[2], l1[3], h1[0], h1[1], h1[2], h1[3]}, o[d0]);   \
        o[d0] = MFMA32(pa2, (bf16x8){l2[0], l2[1], l2[2], l2[3], h2[0], h2[1], h2[2], h2[3]}, o[d0]);   \
        o[d0] = MFMA32(pa3, (bf16x8){l3[0], l3[1], l3[2], l3[3], h3[0], h3[1], h3[2], h3[3]}, o[d0]); } while (0)
    PV_D0(0); PV_D0(1); PV_D0(2); PV_D0(3);
#undef PV_D0
#undef TRRD
}
template <int HALF> __device__ __forceinline__ void qkt_half(f32x16& p, const LAS char* Kb, int r32, int hi, const bf16x8* qr) {
    p = f32x16{};
    const LAS char* kb[4];
#pragma unroll
    for (int dd = 0; dd < 4; ++dd) kb[dd] = Kb + KSWZ(r32, (dd * 16 + hi * 8) * 2);
#pragma unroll
    for (int d0 = 0; d0 < 8; ++d0) { const LAS char* a = kb[d0 & 3] + (d0 >> 2) * 128 + HALF * 32 * 256;
        p = MFMA32(*(const LAS bf16x8*)a, qr[d0], p); }
}
template <int HALF> __device__ __forceinline__ void pv_half(f32x16* o, int vb0, bf16x8 pa0, bf16x8 pa1) {
#define TRRD(dst, off) asm volatile("ds_read_b64_tr_b16 %0, %1 offset:%2" : "=&v"(dst) : "v"(vb0), "i"(off) : "memory")
#define PV_D0(d0) do { s16x4 l0, l1, h0, h1; constexpr int b_ = v_rd_off(d0, 2 * HALF, 0); \
        TRRD(l0, b_); TRRD(h0, b_ + 2048); TRRD(l1, b_ + 4096); TRRD(h1, b_ + 6144); \
        asm volatile("s_waitcnt lgkmcnt(0)" ::: "memory"); SBAR(); \
        o[d0] = MFMA32(pa0, (bf16x8){l0[0], l0[1], l0[2], l0[3], h0[0], h0[1], h0[2], h0[3]}, o[d0]);   \
        o[d0] = MFMA32(pa1, (bf16x8){l1[0], l1[1], l1[2], l1[3], h1[0], h1[1], h1[2], h1[3]}, o[d0]); } while (0)
    PV_D0(0); PV_D0(1); PV_D0(2); PV_D0(3);
#undef PV_D0
#undef TRRD
}
typedef short v4i16_t __attribute__((ext_vector_type(4)));
__device__ __forceinline__ s16x4 vtr(const LAS char* p) { return __builtin_bit_cast(s16x4, __builtin_amdgcn_ds_read_tr16_b64_v4i16((LAS v4i16_t*)p)); }
template <int HALF> __device__ __forceinline__ void pv_half_b(f32x16* o, const LAS char* vbp, bf16x8 pa0, bf16x8 pa1) {
#pragma unroll
    for (int d0 = 0; d0 < 4; ++d0) { const LAS char* b_ = vbp + v_rd_off(d0, 2 * HALF, 0);
        const s16x4 l0 = vtr(b_), h0 = vtr(b_ + 2048), l1 = vtr(b_ + 4096), h1 = vtr(b_ + 6144);
        o[d0] = MFMA32(pa0, (bf16x8){l0[0], l0[1], l0[2], l0[3], h0[0], h0[1], h0[2], h0[3]}, o[d0]);
        o[d0] = MFMA32(pa1, (bf16x8){l1[0], l1[1], l1[2], l1[3], h1[0], h1[1], h1[2], h1[3]}, o[d0]); }
}
__device__ __forceinline__ float dot2_ones(unsigned w, float acc) { return __builtin_amdgcn_fdot2(__builtin_bit_cast(pg8::h16x2, w), (pg8::h16x2){(_Float16)1.0f, (_Float16)1.0f}, acc, false); }
__device__ __forceinline__ float pack_half(const f32x16& p, bf16x8& pa0, bf16x8& pa1) {
    float ps = 0.f;
#define PK4(P, B_, OUT) do { unsigned a0 = cvtpk(P[B_+0], P[B_+1]), a1 = cvtpk(P[B_+2], P[B_+3]);                          \
        unsigned b0 = cvtpk(P[B_+4], P[B_+5]), b1 = cvtpk(P[B_+6], P[B_+7]);                                             \
        ps = dot2_ones(a0, ps); ps = dot2_ones(a1, ps); ps = dot2_ones(b0, ps); ps = dot2_ones(b1, ps);                     \
        auto r0 = __builtin_amdgcn_permlane32_swap(a0, b0, false, false); auto r1 = __builtin_amdgcn_permlane32_swap(a1, b1, false, false); \
        u32x4 w = {r0[0], r1[0], r0[1], r1[1]}; OUT = *reinterpret_cast<bf16x8*>(&w); } while (0)
    PK4(p, 0, pa0); PK4(p, 8, pa1);
#undef PK4
    return ps;
}
__device__ __forceinline__ void pack_p(const f32x16& p0, const f32x16& p1, bf16x8& pa0, bf16x8& pa1, bf16x8& pa2, bf16x8& pa3) {
#define PK4(P, B_, OUT) do { unsigned a0 = cvtpk(P[B_+0], P[B_+1]), a1 = cvtpk(P[B_+2], P[B_+3]);                          \
        unsigned b0 = cvtpk(P[B_+4], P[B_+5]), b1 = cvtpk(P[B_+6], P[B_+7]);                                             \
        auto r0 = __builtin_amdgcn_permlane32_swap(a0, b0, false, false); auto r1 = __builtin_amdgcn_permlane32_swap(a1, b1, false, false); \
        u32x4 w = {r0[0], r1[0], r0[1], r1[1]}; OUT = *reinterpret_cast<bf16x8*>(&w); } while (0)
    PK4(p0, 0, pa0); PK4(p0, 8, pa1); PK4(p1, 0, pa2); PK4(p1, 8, pa3);
#undef PK4
}
__device__ __forceinline__ float swap_other(float own, int hi) {
    auto rr = __builtin_amdgcn_permlane32_swap(__float_as_uint(own), __float_as_uint(own), false, false);
    return hi ? __uint_as_float(rr[0]) : __uint_as_float(rr[1]);
}
struct Stage { bf16x8 k0, k1, v0, v1; };
__device__ __forceinline__ void stage_load(Stage& S, const bf16* Kp, const bf16* Vp, int key0, int sr, int sc) {
    const bf16* kp = Kp + (size_t)(key0 + sr) * PITCH + sc; const bf16* vp = Vp + (size_t)(key0 + sr) * PITCH + sc;
    S.k0 = *(const bf16x8*)kp; S.k1 = *(const bf16x8*)(kp + 32 * PITCH); S.v0 = *(const bf16x8*)vp; S.v1 = *(const bf16x8*)(vp + 32 * PITCH);
}
__device__ __forceinline__ void stage_write(const Stage& S, LAS char* Kl, LAS char* Vl, int kws, int vst0, int vst1) {
    *(LAS bf16x8*)(Kl + kws) = S.k0; *(LAS bf16x8*)(Kl + kws + 32 * 256) = S.k1; *(LAS bf16x8*)(Vl + vst0) = S.v0; *(LAS bf16x8*)(Vl + vst1) = S.v1;
}
__device__ __forceinline__ void store_o(const f32x16* o, const float* rscale  , bf16* Ow, int r32, int hi) {
    int lo = 4 * hi * PITCH + r32; asm volatile("" : "+v"(lo));
#pragma unroll
    for (int r = 0; r < 16; ++r) { const int orow = (r & 3) + 8 * (r >> 2);
#pragma unroll
        for (int d0 = 0; d0 < 4; ++d0) { const float v = rscale ? o[d0][r] * rscale[r] : o[d0][r]; const float vn = __shfl_xor(v, 1);
            if ((r32 & 1) == 0) *(unsigned*)(Ow + (size_t)(lo + orow * PITCH + d0 * 32)) = cvtpk(v, vn); } }
}

__device__ __forceinline__ void sb_math(f32x16& p0, f32x16& p1, float& R, int dq, bool need_mask, int hi) {
    constexpr float C2 = QK_SCALE * LOG2E;
    f32x16 k0, k1;
#pragma unroll
    for (int r = 0; r < 16; ++r) {
        const int c = (r & 3) + 8 * (r >> 2);
        { const float x = p0[r] * C2, t = __builtin_amdgcn_exp2f(-fabsf(x)), rr = __builtin_amdgcn_rcpf(1.0f + t), tr = t * rr; const bool pos = x >= 0.f;
          float be = pos ? rr : tr, ke = pos ? tr : rr; if (need_mask && !(c < dq)) { be = 0.f; ke = 1.f; } p0[r] = be; k0[r] = ke; }
        { const float x = p1[r] * C2, t = __builtin_amdgcn_exp2f(-fabsf(x)), rr = __builtin_amdgcn_rcpf(1.0f + t), tr = t * rr; const bool pos = x >= 0.f;
          float be = pos ? rr : tr, ke = pos ? tr : rr; if (need_mask && !(c + 32 < dq)) { be = 0.f; ke = 1.f; } p1[r] = be; k1[r] = ke; }
    }
    float L[9]; L[0] = 1.0f;
#pragma unroll
    for (int j = 0; j < 8; ++j) { const int g = 3 - (j & 3); const f32x16& kk = (j < 4) ? k1 : k0; L[j + 1] = L[j] * ((kk[4 * g] * kk[4 * g + 1]) * (kk[4 * g + 2] * kk[4 * g + 3])); }
#pragma unroll
    for (int j = 0; j < 8; ++j) {
        auto rr = __builtin_amdgcn_permlane32_swap(__float_as_uint(L[j + 1]), __float_as_uint(L[j]), false, false);
        const float foreign = hi ? __uint_as_float(rr[0]) : __uint_as_float(rr[1]);
        float P = R * (L[j] * foreign);
        const int g = 3 - (j & 3);
        if (j < 4) { p1[4 * g + 3] *= P; P *= k1[4 * g + 3]; p1[4 * g + 2] *= P; P *= k1[4 * g + 2]; p1[4 * g + 1] *= P; P *= k1[4 * g + 1]; p1[4 * g] *= P; }
        else       { p0[4 * g + 3] *= P; P *= k0[4 * g + 3]; p0[4 * g + 2] *= P; P *= k0[4 * g + 2]; p0[4 * g + 1] *= P; P *= k0[4 * g + 1]; p0[4 * g] *= P; }
    }
    R = R * (L[8] * swap_other(L[8], hi));
}
__device__ __forceinline__ void sb_block(const Frame& F, int b, int h, int qb, const bf16* Qb, const bf16* Kb, const bf16* Vb, bf16* Ob) {
    LAS char* lds = (LAS char*)F.lds;
    const int tid = F.tid, wid = F.wave, lane = F.lane, r32 = lane & 31, hi = lane >> 5;
    const int t0 = qb * 256, tq = t0 + wid * 32 + r32;
    const size_t rowbase = (size_t)b * SEQ;
    const bf16* Qp = Qb + (rowbase + t0) * PITCH + h * HD; bf16* Op = Ob + (rowbase + t0) * PITCH + h * HD;
    const bf16* Kp = Kb + rowbase * PITCH + h * HD; const bf16* Vp = Vb + rowbase * PITCH + h * HD;
    bf16x8 qr[8];
#pragma unroll
    for (int d0 = 0; d0 < 8; ++d0) qr[d0] = *(const bf16x8*)(Qp + (size_t)(wid * 32 + r32) * PITCH + d0 * 16 + hi * 8);
    const int sr = tid >> 4, sc = (tid & 15) * 8, kws = KSWZ(sr, sc * 2), vst0 = v_st(sr, sc), vst1 = vst0 + 8192  ;
    LAS char* Vl = lds + OFF_V; LAS char* Kl = lds + OFF_K;
    LAS unsigned* flags = (LAS unsigned*)(lds + OFF_FLAG);
    const int vb = (int)(size_t)Vl + v_rd_base(lane);
    float R = 1.0f; f32x16 o[4] = {};
    const int jmax = (t0 + 254) >> 6;
    const int jw = (t0 + wid * 32 + 30) >> 6;
    bool wdone = false;
    if (tid < 8) flags[tid] = 0u;
    Stage S; stage_load(S, Kp, Vp, jmax * 64, sr, sc); stage_write(S, Kl, Vl, kws, vst0, vst1);
    __syncthreads();
    int buf = 0;
    for (int j = jmax; j >= 0; --j) {
        if (j > 0) stage_load(S, Kp, Vp, (j - 1) * 64, sr, sc);
        if (!wdone && j <= jw) {
            f32x16 p0, p1; qkt(p0, p1, Kl + buf * SHM_T, r32, hi, qr);
            sb_math(p0, p1, R, tq - 64 * j - 4 * hi, 64 * j + 63 >= t0 + wid * 32, hi);
            bf16x8 pa0, pa1, pa2, pa3; pack_p(p0, p1, pa0, pa1, pa2, pa3);
            pv_tile(o, vb + buf * SHM_T, pa0, pa1, pa2, pa3);
#ifndef PROBE_NO_EXIT
            if (__all(R < 1e-30f)) { wdone = true; if (lane == 0) flags[wid] = 1u; }
#endif
        }
        if (j > 0) stage_write(S, Kl + (buf ^ 1) * SHM_T, Vl + (buf ^ 1) * SHM_T, kws, vst0, vst1);
        __syncthreads();
        buf ^= 1;
        if (j > 0) { const u32x4 f0 = *(const LAS u32x4*)flags, f1 = *(const LAS u32x4*)(flags + 4);
            if ((f0.x & f0.y & f0.z & f0.w & f1.x & f1.y & f1.z & f1.w) != 0u) break; }
    }
#ifdef PROBE_ZERO_SB
#pragma unroll
    for (int d = 0; d < 4; ++d) o[d] = f32x16{};
#endif
    store_o(o, nullptr, Op + (size_t)(wid * 32) * PITCH, r32, hi);
    __syncthreads();
}

__device__ __forceinline__ int t5_bucket(int n) {
    if (n < 16) return n;
    const int th[15] = {19, 21, 24, 27, 31, 35, 40, 46, 52, 59, 67, 77, 87, 99, 113};
    int bkt = 16;
#pragma unroll
    for (int i = 0; i < 15; ++i) bkt += (n >= th[i]) ? 1 : 0;
    return bkt;
}
__device__ __forceinline__ void dsa_block(const Frame& F, int b, int h, int qb, const bf16* Qb, const bf16* Kb, const bf16* Vb, bf16* Ob, const u64* BM, const float* relbias) {
    LAS char* lds = (LAS char*)F.lds;
    const int tid = F.tid, wid = F.wave, lane = F.lane, r32 = lane & 31, hi = lane >> 5;
    const int t0 = qb * 256, tq = t0 + wid * 32 + r32;
    const size_t rowbase = (size_t)b * SEQ;
    const bf16* Qp = Qb + (rowbase + t0) * PITCH + h * HD; bf16* Op = Ob + (rowbase + t0) * PITCH + h * HD;
    const bf16* Kp = Kb + rowbase * PITCH + h * HD; const bf16* Vp = Vb + rowbase * PITCH + h * HD;
    const u64* bmrow = BM + (rowbase + tq) * 128;
    bf16x8 qr[8];
#pragma unroll
    for (int d0 = 0; d0 < 8; ++d0) qr[d0] = *(const bf16x8*)(Qp + (size_t)(wid * 32 + r32) * PITCH + d0 * 16 + hi * 8);
    const int sr = tid >> 4, sc = (tid & 15) * 8, kws = KSWZ(sr, sc * 2), vst0 = v_st(sr, sc), vst1 = vst0 + 8192  ;
    LAS char* Vl = lds + OFF_V; LAS char* Kl = lds + OFF_K;
    LAS float* ws = (LAS float*)(lds + OFF_WS) + wid * 64; LAS float* li_l = ws; LAS float* al_l = ws + 32;
    LAS float* btab = (LAS float*)(lds + OFF_TAB);
    if (tid < 128) btab[tid] = relbias[t5_bucket(tid) * NHEAD + h] * LOG2E;
    const float bfar = relbias[31 * NHEAD + h] * LOG2E;
    const int vb = (int)(size_t)Vl + v_rd_base(lane);
    float m_reg = -1e30f, l_reg = 0.f; f32x16 o[4] = {};
    const int jmax = (t0 + 255) >> 6;
    const int jw = (t0 + wid * 32 + 31) >> 6;
    constexpr float C2 = QK_SCALE * LOG2E, THR2 = 8.0f * LOG2E, NEG = -__builtin_inff();
    Stage S; stage_load(S, Kp, Vp, 0, sr, sc); stage_write(S, Kl, Vl, kws, vst0, vst1);
    __syncthreads();
    int buf = 0;
#define DSA_RESC(alpha) do { if (__any(alpha < 1.0f)) { if (hi == 0) al_l[r32] = alpha; LDS_WAIT(); \
                _Pragma("unroll") for (int r = 0; r < 16; ++r) { const float a = al_l[crow(r, hi)]; \
                    _Pragma("unroll") for (int d = 0; d < 4; ++d) o[d][r] *= a; } \
                LDS_WAIT(); } } while (0)
#define DSA_SMF(HALF, p, pa0, pa1, alpha) do { \
            const unsigned mk = (unsigned)(mw >> (32 * HALF)) >> (4 * hi); \
            _Pragma("unroll") for (int r = 0; r < 16; ++r) { const int c = (r & 3) + 8 * (r >> 2); const unsigned m = (unsigned)__builtin_amdgcn_sbfe((int)mk, c, 1); \
                p[r] = __uint_as_float((__float_as_uint(p[r]) & m) | (0xff800000u & ~m)); } \
            float pmax = p[0]; _Pragma("unroll") for (int r = 1; r < 16; ++r) pmax = fmaxf(pmax, p[r]); \
            pmax = fmaf(pmax, C2, bfar); pmax = fmaxf(pmax, swap_other(pmax, hi)); \
            const bool keep = __all(pmax - m_reg <= THR2); \
            const float mn = keep ? m_reg : fmaxf(m_reg, pmax); \
            alpha = __builtin_amdgcn_exp2f(m_reg - mn); m_reg = mn; \
            const float kk = bfar - mn; \
            _Pragma("unroll") for (int r = 0; r < 16; ++r) p[r] = __builtin_amdgcn_exp2f(fmaf(p[r], C2, kk)); \
            float ps = pack_half(p, pa0, pa1); ps += swap_other(ps, hi); l_reg = l_reg * alpha + ps; } while (0)
#define DSA_SMN(HALF, p, pa0, pa1, alpha) do { \
            const unsigned mk = (unsigned)(mw >> (32 * HALF)) >> (4 * hi); \
            const int dq = tq - 64 * j - 32 * HALF - 4 * hi;             \
            _Pragma("unroll") for (int r = 0; r < 16; ++r) { const int c = (r & 3) + 8 * (r >> 2); int n0 = dq - c; n0 = n0 < 0 ? 0 : (n0 > 127 ? 127 : n0); \
                const float x0 = p[r] * C2 + btab[n0]; p[r] = ((mk >> c) & 1u) ? x0 : NEG; } \
            float pmax = p[0]; _Pragma("unroll") for (int r = 1; r < 16; ++r) pmax = fmaxf(pmax, p[r]); \
            pmax = fmaxf(pmax, swap_other(pmax, hi)); \
            const bool keep = __all(pmax - m_reg <= THR2); \
            const float mn = keep ? m_reg : fmaxf(m_reg, pmax); \
            alpha = __builtin_amdgcn_exp2f(m_reg - mn); m_reg = mn; \
            _Pragma("unroll") for (int r = 0; r < 16; ++r) p[r] = __builtin_amdgcn_exp2f(p[r] - mn); \
            float ps = pack_half(p, pa0, pa1); ps += swap_other(ps, hi); l_reg = l_reg * alpha + ps; } while (0)
#define SGB_MFMA_VALU(nm, nv) do { _Pragma("unroll") for (int g_ = 0; g_ < (nm); ++g_) { __builtin_amdgcn_sched_group_barrier(0x008, 1, 0); __builtin_amdgcn_sched_group_barrier(0x002, (nv), 0); } } while (0)
#define DSA_SMF2(p0, p1, pa0, pa1, pa2, pa3, alpha) do { \
            const unsigned mk0 = (unsigned)mw >> (4 * hi), mk1 = (unsigned)(mw >> 32) >> (4 * hi); \
            _Pragma("unroll") for (int r = 0; r < 16; ++r) { const int c = (r & 3) + 8 * (r >> 2); \
                const unsigned m0 = (unsigned)__builtin_amdgcn_sbfe((int)mk0, c, 1), m1 = (unsigned)__builtin_amdgcn_sbfe((int)mk1, c, 1); \
                p0[r] = __uint_as_float((__float_as_uint(p0[r]) & m0) | (0xff800000u & ~m0)); p1[r] = __uint_as_float((__float_as_uint(p1[r]) & m1) | (0xff800000u & ~m1)); } \
            float pmax = fmaxf(p0[0], p1[0]); _Pragma("unroll") for (int r = 1; r < 16; ++r) pmax = fmaxf(pmax, fmaxf(p0[r], p1[r])); \
            pmax = fmaf(pmax, C2, bfar); pmax = fmaxf(pmax, swap_other(pmax, hi)); \
            const bool keep = __all(pmax - m_reg <= THR2); \
            const float mn = keep ? m_reg : fmaxf(m_reg, pmax); \
            alpha = __builtin_amdgcn_exp2f(m_reg - mn); m_reg = mn; \
            const float kk = bfar - mn; \
            _Pragma("unroll") for (int r = 0; r < 16; ++r) p0[r] = __builtin_amdgcn_exp2f(fmaf(p0[r], C2, kk)); \
            float ps = pack_half(p0, pa0, pa1); \
            _Pragma("unroll") for (int r = 0; r < 16; ++r) p1[r] = __builtin_amdgcn_exp2f(fmaf(p1[r], C2, kk)); \
            ps += pack_half(p1, pa2, pa3); ps += swap_other(ps, hi); l_reg = l_reg * alpha + ps; } while (0)
    int J1 = ((t0 - 176) >> 6) + 1; J1 = J1 < 0 ? 0 : (J1 > jmax + 1 ? jmax + 1 : J1);
    int j = 0, vi = 0;
    u64 mw_next = bmrow[0];
    if (wid < 4) {
        for (; j < J1; ++j) {
            const u64 mw = mw_next; if (j < jw) mw_next = bmrow[j + 1];
            if (j < jmax) stage_load(S, Kp, Vp, (j + 1) * 64, sr, sc);
            const int vn = vi == 2 ? 0 : vi + 1;
            {
                f32x16 pA, pB; bf16x8 a0, a1, b0, b1; float al0, al1;
                const LAS char* vbp = Vl + vi * SHM_T + v_rd_base(lane);
                SBAR(); qkt_half<0>(pA, Kl + buf * SHM_T, r32, hi, qr); SBAR();
                qkt_half<1>(pB, Kl + buf * SHM_T, r32, hi, qr);
                DSA_SMF(0, pA, a0, a1, al0);
                SGB_MFMA_VALU(8, 14);
                SBAR(); DSA_RESC(al0); SBAR();
                pv_half_b<0>(o, vbp, a0, a1);
                DSA_SMF(1, pB, b0, b1, al1);
                SGB_MFMA_VALU(8, 14);
                SBAR(); DSA_RESC(al1); SBAR();
                pv_half_b<1>(o, vbp, b0, b1);
                SBAR();
            }
            if (j < jmax) stage_write(S, Kl + (buf ^ 1) * SHM_T, Vl + vn * SHM_T, kws, vst0, vst1);
            __syncthreads();
            buf ^= 1; vi = vn;
        }
    } else {
        bf16x8 c0 = {}, c1 = {}, c2 = {}, c3 = {}; int vp_ = 0;
        for (; j < J1; ++j) {
            const u64 mw = mw_next; if (j < jw) mw_next = bmrow[j + 1];
            if (j < jmax) stage_load(S, Kp, Vp, (j + 1) * 64, sr, sc);
            const int vn = vi == 2 ? 0 : vi + 1;
            {
                f32x16 pA, pB; float al;
                if (j > 0) { const LAS char* vbp = Vl + vp_ * SHM_T + v_rd_base(lane);
                    SBAR(); pv_half_b<0>(o, vbp, c0, c1); pv_half_b<1>(o, vbp, c2, c3); }
                SBAR(); qkt_half<0>(pA, Kl + buf * SHM_T, r32, hi, qr); SBAR();
                qkt_half<1>(pB, Kl + buf * SHM_T, r32, hi, qr); SBAR();
                DSA_SMF2(pA, pB, c0, c1, c2, c3, al);
                SBAR(); DSA_RESC(al); SBAR();
            }
            if (j < jmax) stage_write(S, Kl + (buf ^ 1) * SHM_T, Vl + vn * SHM_T, kws, vst0, vst1);
            __syncthreads();
            buf ^= 1; vp_ = vi; vi = vn;
        }
        if (J1 > 0) { const LAS char* vbp = Vl + vp_ * SHM_T + v_rd_base(lane);
            SBAR(); pv_half_b<0>(o, vbp, c0, c1); pv_half_b<1>(o, vbp, c2, c3); SBAR(); }
    }
    for (; j <= jmax; ++j) {
        const u64 mw = mw_next; if (j < jw) mw_next = bmrow[j + 1];
        if (j < jmax) stage_load(S, Kp, Vp, (j + 1) * 64, sr, sc);
        if (j <= jw) {
            const bool nearT = (t0 + wid * 32) - (64 * j + 63) < 113;
            f32x16 pA, pB; bf16x8 a0, a1, b0, b1; float al0, al1;
            SBAR(); qkt_half<0>(pA, Kl + buf * SHM_T, r32, hi, qr);
            qkt_half<1>(pB, Kl + buf * SHM_T, r32, hi, qr);
            SBAR(); if (nearT) DSA_SMN(0, pA, a0, a1, al0); else DSA_SMF(0, pA, a0, a1, al0);
            SBAR(); DSA_RESC(al0); SBAR();
            pv_half<0>(o, vb + vi * SHM_T, a0, a1);
            SBAR(); if (nearT) DSA_SMN(1, pB, b0, b1, al1); else DSA_SMF(1, pB, b0, b1, al1);
            SBAR(); DSA_RESC(al1); SBAR();
            pv_half<1>(o, vb + vi * SHM_T, b0, b1);
            SBAR();
        }
        const int vn = vi == 2 ? 0 : vi + 1;
        if (j < jmax) stage_write(S, Kl + (buf ^ 1) * SHM_T, Vl + vn * SHM_T, kws, vst0, vst1);
        __syncthreads();
        buf ^= 1; vi = vn;
    }
#undef DSA_SMF
#undef DSA_SMF2
#undef DSA_SMN
#undef DSA_RESC
#undef SGB_MFMA_VALU
    if (hi == 0) li_l[r32] = l_reg; LDS_WAIT();
    float rli[16];
#pragma unroll
    for (int r = 0; r < 16; ++r) rli[r] = __builtin_amdgcn_rcpf(li_l[crow(r, hi)]);
#ifdef PROBE_ZERO_DS
#pragma unroll
    for (int r = 0; r < 16; ++r) rli[r] = 0.f;
#endif
#ifdef PROBE_ZERO_DS_LATE
    if (t0 >= 256) {
#pragma unroll
    for (int r = 0; r < 16; ++r) rli[r] = 0.f; }
#endif
    store_o(o, rli, Op + (size_t)(wid * 32) * PITCH, r32, hi);
    __syncthreads();
}
#undef KSWZ
}

namespace idx {
__device__ __forceinline__ unsigned fkey(float s) {
    const _Float16 hh = (_Float16)s; unsigned bits = (unsigned)__builtin_bit_cast(unsigned short, hh);
#ifdef PROBE_COARSE_KEYS
    bits &= ~(unsigned)PROBE_COARSE_KEYS;
#endif
    return (bits & 0x8000u) ? (~bits & 0xffffu) : (bits | 0x8000u);
}
template <int CTRL> __device__ __forceinline__ int dpp_mov(int v) { return __builtin_amdgcn_update_dpp(0, v, CTRL, 0xf, 0xf, false); }
__device__ __forceinline__ int wave_sum_dpp(int x) {
    x += dpp_mov<0xB1>(x); x += dpp_mov<0x4E>(x); x += dpp_mov<0x141>(x); x += dpp_mov<0x140>(x);
    return __builtin_amdgcn_readlane(x, 0) + __builtin_amdgcn_readlane(x, 16) + __builtin_amdgcn_readlane(x, 32) + __builtin_amdgcn_readlane(x, 48);
}
__device__ __forceinline__ unsigned count_ge(const u32x4 (&dat)[16], int jn, unsigned cand) {
    const unsigned cm1 = __builtin_amdgcn_readfirstlane((cand - 1u) | ((cand - 1u) << 16)), one2 = 0x00010001u;
    unsigned acc = 0u;
#pragma unroll
    for (int j = 0; j < 16; ++j) if (j < jn) {
#pragma unroll
        for (int e = 0; e < 4; ++e) { unsigned d;
            asm volatile("v_pk_sub_u16 %0, %2, %3 clamp\n\tv_pk_min_u16 %0, %0, %4\n\tv_pk_add_u16 %1, %1, %0" : "=&v"(d), "+v"(acc) : "v"(dat[j][e]), "s"(cm1), "s"(one2)); } }
    return (unsigned)wave_sum_dpp((int)(acc & 0xffffu) + (int)(acc >> 16));
}
__device__ __forceinline__ void load_af(bf16x8 (&af)[4][4], const bf16* QIX, size_t row0, int r32, int hi) {
#pragma unroll
    for (int rt = 0; rt < 4; ++rt) { const int q = 2 * rt + ((r32 >> 2) & 1), hd = (r32 & 3) + 4 * (r32 >> 3);
#pragma unroll
        for (int ks = 0; ks < 4; ++ks) af[rt][ks] = *(const bf16x8*)(QIX + (row0 + q) * WATT + hd * IDIM + ks * 16 + hi * 8); }
}
struct PrepRegs { float wv; float w16[NIH]; unsigned short q16[NIH]; };
__device__ __forceinline__ void prep_issue(PrepRegs& R, const Frame& F, const bf16* QIX, const float* WIX, size_t row0) {
    R.wv = (F.tid < 128) ? WIX[row0 * NIH + F.tid] : 0.f;
    const int q = F.tid >> 6, d = F.tid & 63;
#pragma unroll
    for (int hd = 0; hd < NIH; ++hd) { R.w16[hd] = WIX[(row0 + q) * NIH + hd]; R.q16[hd] = QIX[(row0 + q) * WATT + hd * IDIM + d]; }
}
__device__ __forceinline__ void prep_commit(const PrepRegs& R, const Frame& F, int par) {
    LAS float* WL = (LAS float*)(F.lds + EXTRA_OFF + par * 2048);
    LAS unsigned short* QL = (LAS unsigned short*)(F.lds + EXTRA_OFF + par * 2048 + 512);
    if (F.tid < 128) WL[F.tid] = R.wv;
    float a = 0.f;
#pragma unroll
    for (int hd = 0; hd < NIH; ++hd) a = fmaf(R.w16[hd], (float)__builtin_bit_cast(_Float16, R.q16[hd]), a);
    QL[(F.tid >> 6) * IDIM + (F.tid & 63)] = __builtin_bit_cast(unsigned short, (_Float16)a);
}
__device__ __forceinline__ void unit(const Frame& F, int b, int t0, bool has_next, int nb, int nt0, bf16x8 (&af)[4][4], int par, const bf16* QIX, const bf16* KIX, const float* WIX, unsigned char* BM) {
    LAS unsigned short* SC = (LAS unsigned short*)F.lds;
    const int wave = F.wave, lane = F.lane, r32 = lane & 31, hi = lane >> 5;
    const size_t rowbase = (size_t)b * SEQ;
    const int ntile = (t0 + 8 + 31) >> 5;
#ifdef PROBE_TIME
    LAS unsigned long long* TA = (LAS unsigned long long*)(F.lds + EXTRA_OFF + 6144); unsigned long long tp0 = clock64();
#define TSTAMP(k) do { const unsigned long long tn_ = clock64(); if (F.tid == 0) TA[k] += tn_ - tp0; tp0 = tn_; } while (0)
#else
#define TSTAMP(k) do {} while (0)
#endif
    __syncthreads();
    {
        LAS float* WL = (LAS float*)(F.lds + EXTRA_OFF + par * 2048);
        LAS unsigned short* QL = (LAS unsigned short*)(F.lds + EXTRA_OFF + par * 2048 + 512);
        bf16x8 af5[4];
        {   const int q5 = 2 * (r32 & 3) + ((r32 >> 2) & 1);
#pragma unroll
            for (int ks = 0; ks < 4; ++ks) { u32x4 pk = *(const LAS u32x4*)(QL + q5 * IDIM + ks * 16 + hi * 8); if (r32 >= 8) pk = (u32x4){0u, 0u, 0u, 0u}; af5[ks] = __builtin_bit_cast(bf16x8, pk); }
        }
        TSTAMP(0);
        bf16x8 bnx[4];
        if (wave < ntile) {
#pragma unroll
            for (int ks = 0; ks < 4; ++ks) bnx[ks] = *(const bf16x8*)(KIX + (rowbase + wave * 32) * IDIM + ((ks * 2 + hi) * 32 + r32) * 8); }
        for (int jt = wave; jt < ntile; jt += NWAVES) {
            const int key = jt * 32 + r32;
            bf16x8 bfr[4];
#pragma unroll
            for (int ks = 0; ks < 4; ++ks) bfr[ks] = bnx[ks];
            if (jt + NWAVES < ntile) {
#pragma unroll
                for (int ks = 0; ks < 4; ++ks) bnx[ks] = *(const bf16x8*)(KIX + (rowbase + (jt + NWAVES) * 32) * IDIM + ((ks * 2 + hi) * 32 + r32) * 8); }
            f32x16 acc5 = {};
#pragma unroll
            for (int ks = 0; ks < 4; ++ks) acc5 = MFMA32(af5[ks], bfr[ks], acc5);
            f32x16 accA = {};
#pragma unroll
            for (int ks = 0; ks < 4; ++ks) accA = MFMA32(af[0][ks], bfr[ks], accA);
#pragma unroll
            for (int rt = 0; rt < 4; ++rt) {
                f32x16 accN = {};
                if (rt < 3) {
#pragma unroll
                    for (int ks = 0; ks < 4; ++ks) accN = MFMA32(af[rt + 1][ks], bfr[ks], accN); }
                float s = acc5[rt];
                f32x4 wq4[4];
#pragma unroll
                for (int i = 0; i < 4; ++i) wq4[i] = *(const LAS f32x4*)(WL + (2 * rt + hi) * NIH + 4 * i);
#pragma unroll
                for (int r = 0; r < 16; ++r) s = fmaf(wq4[r >> 2][r & 3], fabsf(accA[r]), s);
                asm volatile("" : "+v"(s));
                const int q = 2 * rt + hi;
                const unsigned code = fkey(s);
                SC[q * 8192 + key] = (unsigned short)((key <= t0 + q) ? code : 0u);
                if (rt < 3) {
                    __builtin_amdgcn_sched_group_barrier(0x100, 4, 0);
#pragma unroll
                    for (int g_ = 0; g_ < 4; ++g_) { __builtin_amdgcn_sched_group_barrier(0x008, 1, 0); __builtin_amdgcn_sched_group_barrier(0x002, 7, 0); } }
                accA = accN;
            }
        }
    }
    TSTAMP(1);
    __syncthreads();
    TSTAMP(2);
    PrepRegs PR;
    if (has_next) { load_af(af, QIX, (size_t)nb * SEQ + nt0, r32, hi); prep_issue(PR, F, QIX, WIX, (size_t)nb * SEQ + nt0); }
    {
        const int t = t0 + wave, nch = ntile * 4, jn = (nch + 63) >> 6;
        u32x4 dat[16];
#pragma unroll
        for (int j = 0; j < 16; ++j) { const int c = j * 64 + lane; dat[j] = (c < nch) ? *(const LAS u32x4*)(SC + wave * 8192 + c * 8) : (u32x4){0u, 0u, 0u, 0u}; }
        unsigned T = 0u; int need = 0;
        if (t >= TOPK) {
            for (int bit = 15; bit >= 0; --bit) { const unsigned cand = T | (1u << bit); if (count_ge(dat, jn, cand) >= (unsigned)TOPK) T = cand; }
            const unsigned cgt = (T == 0xffffu) ? 0u : count_ge(dat, jn, T + 1u);
            need = TOPK - (int)cgt;
        }
        TSTAMP(3);
        int taken = 0;
#pragma unroll
        for (int j = 0; j < 16; ++j) if (j < jn) {
            const int c = j * 64 + lane;
            unsigned gm = 0u, tm = 0u;
#pragma unroll
            for (int i = 0; i < 8; ++i) { const unsigned k = (dat[j][i >> 1] >> (16 * (i & 1))) & 0xffffu; gm |= (k > T ? 1u : 0u) << i; tm |= (k == T ? 1u : 0u) << i; }
            unsigned byte = gm;
            if (need > taken && __any(tm != 0u)) {
                const int cnt = __builtin_popcount(tm);
                int inc = cnt;
#pragma unroll
                for (int o = 1; o < 64; o <<= 1) { const int v = __shfl_up(inc, o); if (lane >= o) inc += v; }
                const int tot = __shfl(inc, 63);
                int allow = need - taken - (inc - cnt); allow = allow < 0 ? 0 : (allow > 8 ? 8 : allow);
                unsigned tsel = 0u; int k = 0;
#pragma unroll
                for (int i = 0; i < 8; ++i) { const unsigned bt = (tm >> i) & 1u; if (bt && k < allow) tsel |= 1u << i; k += (int)bt; }
                byte |= tsel;
                taken += (tot < need - taken) ? tot : (need - taken);
            }
            {
                const unsigned w4 = (unsigned)dpp_mov<0x00>((int)byte) | ((unsigned)dpp_mov<0x55>((int)byte) << 8) | ((unsigned)dpp_mov<0xAA>((int)byte) << 16) | ((unsigned)dpp_mov<0xFF>((int)byte) << 24);
                if ((lane & 3) == 0 && c < nch) *(unsigned*)(BM + (rowbase + t) * 1024 + c) = w4; }
        }
    }
    TSTAMP(4);
    if (has_next) prep_commit(PR, F, par ^ 1);
    TSTAMP(5);
}
}


__device__ __forceinline__ void kw_gemm(const Frame& F, const bf16* H, const bf16* W, bf16* kix, float* wix, float wscale) {
    LAS float* red = (LAS float*)F.lds;
    const int wave = F.wave, lane = F.lane, rbp = wave & 1, kq = wave >> 1, fr = lane & 15, fq = lane >> 4;
    for (int blk = F.vcu; blk < MROWS / 64; blk += F.G) {
        const int row0 = blk * 64 + rbp * 32;
        f32x4 acc[2][5];
#pragma unroll
        for (int rb = 0; rb < 2; ++rb)
#pragma unroll
            for (int cb = 0; cb < 5; ++cb) acc[rb][cb] = (f32x4){0.f, 0.f, 0.f, 0.f};
        const char* hb = (const char*)(H + (size_t)row0 * DM + kq * 512); const char* wb = (const char*)(W + kq * 512);
        const unsigned lo = (unsigned)(fr * DM + fq * 8) * 2u;
        unsigned of[6];
#pragma unroll
        for (int c = 0; c < 6; ++c) { of[c] = lo + (unsigned)c * (16u * DM * 2u); asm volatile("" : "+v"(of[c])); }
        bf16x8 fb[4][7];
#define KW_LOAD(i, ks) do { fb[i][0] = *(const bf16x8*)(hb + (ks) * 64 + of[0]); fb[i][1] = *(const bf16x8*)(hb + (ks) * 64 + of[1]); \
            _Pragma("unroll") for (int cb = 0; cb < 5; ++cb) fb[i][2 + cb] = *(const bf16x8*)(wb + (ks) * 64 + of[cb]); } while (0)
        KW_LOAD(0, 0); KW_LOAD(1, 1); KW_LOAD(2, 2); KW_LOAD(3, 3);
#pragma unroll
        for (int ks = 0; ks < 16; ++ks) { const int i = ks & 3;
#pragma unroll
            for (int cb = 0; cb < 5; ++cb) {
                acc[0][cb] = __builtin_amdgcn_mfma_f32_16x16x32_f16(__builtin_bit_cast(pg8::h16x8, fb[i][2 + cb]), __builtin_bit_cast(pg8::h16x8, fb[i][0]), acc[0][cb], 0, 0, 0);
                acc[1][cb] = __builtin_amdgcn_mfma_f32_16x16x32_f16(__builtin_bit_cast(pg8::h16x8, fb[i][2 + cb]), __builtin_bit_cast(pg8::h16x8, fb[i][1]), acc[1][cb], 0, 0, 0); }
            SBAR();
            if (ks + 4 < 16) KW_LOAD(i, ks + 4);
            SBAR();
        }
#undef KW_LOAD
        __syncthreads();
#pragma unroll
        for (int rb = 0; rb < 2; ++rb)
#pragma unroll
            for (int cb = 0; cb < 5; ++cb) *(LAS f32x4*)(red + ((((kq * 2 + rbp) * 10 + rb * 5 + cb) * 64 + lane) * 4)) = acc[rb][cb];
        __syncthreads();
#pragma unroll
        for (int rb = 0; rb < 2; ++rb)
#pragma unroll
            for (int c = 0; c < 2; ++c) { const int cb = 2 * kq + c;
                if (cb < 5) { f32x4 v = {0.f, 0.f, 0.f, 0.f};
#pragma unroll
                    for (int q = 0; q < 4; ++q) v += *(const LAS f32x4*)(red + ((((q * 2 + rbp) * 10 + rb * 5 + cb) * 64 + lane) * 4));
                    const size_t row = (size_t)(row0 + rb * 16 + fr);
                    if (cb < 4) { u32x2 w2; w2.x = cvtpk(v[0], v[1]); w2.y = cvtpk(v[2], v[3]);
                        *(u32x2*)(kix + (row >> 5) * 2048 + ((cb * 2 + (fq >> 1)) * 32 + (row & 31)) * 8 + (fq & 1) * 4) = w2; }
                    else *(f32x4*)(wix + row * 16 + fq * 4) = v * wscale; } }
    }
}

__device__ __forceinline__ void conv_fixup(const Frame& F, const float* ghalo, const float* gdef, const float* udef, const float* convw, const float* convb, bf16* act) {
    const int nth = F.G * NWAVES * 64, gt = F.vcu * NWAVES * 64 + F.tid;
    for (int id = gt; id < 512 * (FF / 4); id += nth) {
        const int rowi = id / (FF / 4), f = 4 * (id % (FF / 4)), blk = rowi >> 1, i = rowi & 1;
        const bool first = (blk & 127) == 0;
        const f32x4 z = {0.f, 0.f, 0.f, 0.f};
        const f32x4 g = *(const f32x4*)(gdef + (size_t)rowi * FF + f), u = *(const f32x4*)(udef + (size_t)rowi * FF + f);
        f32x4 g1, g2;
        if (i == 0) { g1 = first ? z : *(const f32x4*)(ghalo + (size_t)((blk - 1) * 2 + 1) * FF + f); g2 = first ? z : *(const f32x4*)(ghalo + (size_t)((blk - 1) * 2) * FF + f); }
        else { g1 = *(const f32x4*)(gdef + (size_t)(blk * 2) * FF + f); g2 = first ? z : *(const f32x4*)(ghalo + (size_t)((blk - 1) * 2 + 1) * FF + f); }
        const f32x4 w0 = *(const f32x4*)(convw + f), w1 = *(const f32x4*)(convw + FF + f), w2 = *(const f32x4*)(convw + 2 * FF + f), cb = *(const f32x4*)(convb + f);
        f32x4 r;
#pragma unroll
        for (int e = 0; e < 4; ++e) { const float a = cb[e] + w0[e] * g2[e] + w1[e] * g1[e] + w2[e] * g[e]; r[e] = a * pg8::sigmoidf_fast(a) * u[e]; }
        u32x2 w; w.x = cvtpk(r[0], r[1]); w.y = cvtpk(r[2], r[3]);
        *(u32x2*)(act + (size_t)(blk * 64 + i) * FF + f) = w;
    }
}

struct Args { const float* in[17]; float* out; unsigned char* ws; int ph_lo, ph_hi; };
__global__ void __launch_bounds__(NWAVES * 64, 2) mk_fwd(Args args) {
    extern __shared__ __attribute__((aligned(16))) unsigned char lds[];
#define FRAME(F) Frame F; { int l_; asm volatile("v_mbcnt_lo_u32_b32 %0, -1, 0\n\tv_mbcnt_hi_u32_b32 %0, -1, %0" : "=v"(l_)); F.lds = (LAS unsigned char*)lds; F.MISC = (volatile LAS unsigned*)(F.lds + MISC_OFF); \
        F.wave = wave0; F.lane = l_; F.tid = wave0 * 64 + l_; F.G = gridDim.x; const int bx_ = blockIdx.x; F.vcu = (F.G % 8 == 0) ? (bx_ % 8) * (F.G / 8) + bx_ / 8 : bx_; }
    const int wave0 = __builtin_amdgcn_readfirstlane((int)threadIdx.x >> 6);
    FRAME(F0);
    unsigned char* ws = args.ws;
    gu32* ctl = (gu32*)(ws + WS_CTL);
    for (int u = F0.tid; u < (LDS_BYTES - LDSCTL_OFF) / 4; u += NWAVES * 64) ((LAS unsigned*)(F0.lds + LDSCTL_OFF))[u] = 0u;
    __syncthreads();
    if (N_LAUNCHES == 1) (void)xcd_barrier_post((unsigned*)(ctl + CW_BAR), F0.MISC + 8, F0.tid == 0);
#define GRID_BAR() do { if (N_LAUNCHES == 1) { XcdBarrier b_; b_.bar = (unsigned*)((gu32*)(ws + WS_CTL) + CW_BAR); b_.x = xb_xcc_id(); b_.st = F.MISC + 8; xcd_barrier(b_, F.tid == 0); } } while (0)
    const int lo = (N_LAUNCHES == 1) ? 0 : args.ph_lo, hi = (N_LAUNCHES == 1) ? NPH : args.ph_hi;
#ifndef PH_MASK
#define PH_MASK 0xfff
#endif
#define IN(k) (((PH_MASK >> (k)) & 1) && lo <= (k) && (k) < hi)
#define BOTH(k) ((IN(k) && IN((k) + 1)) || rep_ + 1 < DUPN(k))
#ifdef PROBE_GEMM_TIME
#define GEMM_TSTAT ((LAS unsigned long long*)(F.lds + EXTRA_OFF + 4096) + 2 * gphase_++)
#else
#define GEMM_TSTAT nullptr
#endif
#ifdef PROBE_DUP
#define DUPN(k) ((k) == PROBE_DUP ? 2 : 1)
#define DUPOUT(k, real) ((PROBE_DUP == (k) && rep_ == 0) ? (bf16*)(w + WS_H) : (real))
#else
#define DUPN(k) 1
#define DUPOUT(k, real) (real)
#endif

    float* out = args.out;
#ifdef PROBE_PHASE_TIME
    const unsigned long long tk0_ = clock64(); unsigned long long tpa_ = 0ull, tpb_ = 0ull;
#endif
#ifdef PROBE_GEMM_TIME
    int gphase_ = 0;
    if (F0.tid < 16) ((LAS unsigned long long*)(F0.lds + EXTRA_OFF + 4096))[F0.tid] = 0ull;
    __syncthreads();
#endif
#define WSP(name) size_t zo_ = 0; int zq = 0; asm volatile("" : "+s"(zo_), "+s"(zq)); unsigned char* name = ws + zo_; FRAME(F)
#define MODP(w) ((float*)((w) + WS_MOD))
#define SEGP(w, i) ((bf16*)((w) + WS_SEG) + (size_t)(i) * (SEG_BYTES / 2))

    for (int rep_ = 0; rep_ < DUPN(0); ++rep_) if (IN(0)) { WSP(w);
        ph0_mod(F, args.in[1 + zq], args.in[2 + zq], args.in[3 + zq], MODP(w));
#ifdef PROBE_DUP_MOD_ONLY
        if (rep_ == 0) { GRID_BAR(); continue; }
#endif
        WPtrs P{args.in[5 + zq], args.in[6 + zq], args.in[7 + zq], args.in[8 + zq], args.in[11 + zq], args.in[12 + zq], args.in[15 + zq], (bf16*)(w + WS_WIN), (bf16*)(w + WS_WOSB), (bf16*)(w + WS_WODS), (bf16*)(w + WS_WOUT), (bf16*)(w + WS_WGU), (bf16*)(w + WS_WDN)};
        ph0_weights(F, P, 0, F.vcu, F.G);
#ifdef WEIGHTS_ALL_IN_P0
        __syncthreads(); ph0_weights(F, P, 1, F.vcu, F.G);
#endif
        if (BOTH(0)) GRID_BAR();
    }
    for (int rep_ = 0; rep_ < DUPN(1); ++rep_) if (IN(1)) { WSP(w); norm_mod_rows<0>(F, args.in[0 + zq], (bf16*)(w + WS_D1), (bf16*)(w + WS_H), (unsigned char*)out + OUT_H8, (float*)(w + WS_SA1), args.in[4 + zq], MODP(w) + 0 * DM, MODP(w) + 1 * DM);
        {
            GAS u32x4* z = (GAS u32x4*)(w + WS_BM); const int n16 = (int)((size_t)MROWS * 1024 / 16);
            for (int i = F.vcu * (NWAVES * 64) + F.tid; i < n16; i += F.G * NWAVES * 64) z[i] = (u32x4){0u, 0u, 0u, 0u}; }
        if (BOTH(1)) GRID_BAR(); }
    for (int rep_ = 0; rep_ < DUPN(2); ++rep_) if (IN(2)) {
      { WSP(w);
        pg8::Gemm g{(bf16*)(w + WS_H), (bf16*)(w + WS_WIN), (bf16*)(w + WS_H), (bf16*)(w + WS_WIN), DM}; pg8::TileOrder S; S.init(MROWS / 256, 12, 1, F.G, (int)blockIdx.x);
        pg8::EpiIn E{SEGP(w, 0), SEG_BYTES / 2, (unsigned char*)out, (bf16*)(w + WS_KIX), (float*)(w + WS_WIX), 0.25f * 0.125f};
        pg8::gemm_phase<pg8::EpiIn, pg8::TileOrder, true, true>(F.lds + RING_OFF, g, S, E, F.tid, GEMM_TSTAT);
      }
        {   WSP(w);
            __syncthreads();
            pg8::Gemm g8{(bf16*)((unsigned char*)out + OUT_H8), (bf16*)(w + WS_WG8), (bf16*)((unsigned char*)out + OUT_H8), (bf16*)(w + WS_WG8), DM / 2}; pg8::TileOrder S8; S8.init(MROWS / 256, 32, 1, F.G, (int)blockIdx.x);
            pg8::EpiGate E8{(unsigned char*)out, (const float*)(w + WS_SA1), SEGP(w, 2), SEG_BYTES / 2};
            pg8::gemm_phase<pg8::EpiGate, pg8::TileOrder, true, true, false, true>(F.lds + RING_OFF, g8, S8, E8, F.tid, nullptr);
            __syncthreads(); }
      { WSP(w);
        kw_gemm(F, (const bf16*)(w + WS_H), (const bf16*)(w + WS_WIN) + (size_t)44 * 256 * DM, (bf16*)(w + WS_KIX), (float*)(w + WS_WIX), 0.25f * 0.125f);
#ifndef WEIGHTS_ALL_IN_P0
        {
            const int nunits = (MROWS / 256) * (N_IN_PAD / 256), full = nunits / F.G, extra = nunits - full * F.G;
            const int bx = (int)blockIdx.x;
            WPtrs P{args.in[5 + zq], args.in[6 + zq], args.in[7 + zq], args.in[8 + zq], args.in[11 + zq], args.in[12 + zq], args.in[15 + zq], (bf16*)(w + WS_WIN), (bf16*)(w + WS_WOSB), (bf16*)(w + WS_WODS), (bf16*)(w + WS_WOUT), (bf16*)(w + WS_WGU), (bf16*)(w + WS_WDN)};
            if (extra == 0 || extra >= F.G) ph0_weights(F, P, 1, bx, F.G);
            else if (bx >= extra) ph0_weights(F, P, 1, bx - extra, F.G - extra);
        }
#endif
      }
        if (BOTH(2)) { FRAME(F); GRID_BAR(); }
    }
    for (int rep_ = 0; rep_ < DUPN(3); ++rep_) if (IN(3)) { WSP(w);
#if defined(PROBE_PHASE_TIME) && PROBE_PHASE_TIME == 0
        tpa_ = clock64();
#endif
#ifdef PROBE_DUP_IDX_ONLY
        if (rep_ == DUPN(3) - 1)
#endif
        for (int u = F.vcu; u < 2 * NHEAD * 32; u += F.G) { const int bh = u >> 5, qb = u & 31; att::sb_block(F, bh >> 3, bh & 7, qb, SEGP(w, 0), SEGP(w, 1), SEGP(w, 2), DUPOUT(3, SEGP(w, 0))); }
#ifdef PROBE_TIME
        if (F.tid < 8) ((LAS unsigned long long*)(F.lds + EXTRA_OFF + 6144))[F.tid] = 0ull;
        __syncthreads();
#endif
#if defined(PROBE_PHASE_TIME) && PROBE_PHASE_TIME == 0
        tpb_ = clock64();
#endif
#if defined(PROBE_PHASE_TIME) && PROBE_PHASE_TIME == 1
        tpa_ = clock64();
#endif
        {   const int NU = BATCH * SEQ / 8, nit = (NU + F.G - 1) / F.G;
#define IDX_ID(i) ((i) * F.G + (((i) & 1) ? (F.G - 1 - F.vcu) : F.vcu))
            const bf16* QIXp = SEGP(w, 6); const bf16* KIXp = (const bf16*)(w + WS_KIX); const float* WIXp = (const float*)(w + WS_WIX);
            bf16x8 af[4][4]; int i = 0;
            while (i < nit && IDX_ID(i) >= NU) ++i;
            if (i < nit) { const int id = IDX_ID(i); const size_t row0 = (size_t)(id & 1) * SEQ + (size_t)(id >> 1) * 8;
                idx::load_af(af, QIXp, row0, F.lane & 31, F.lane >> 5); idx::PrepRegs PR; idx::prep_issue(PR, F, QIXp, WIXp, row0); idx::prep_commit(PR, F, 0); }
            int par = 0;
            while (i < nit) { const int id = IDX_ID(i); int inx = i + 1; while (inx < nit && IDX_ID(inx) >= NU) ++inx;
                const bool hn = inx < nit; const int idn = hn ? IDX_ID(inx) : id;
                idx::unit(F, id & 1, (id >> 1) * 8, hn, idn & 1, (idn >> 1) * 8, af, par, QIXp, KIXp, WIXp, w + WS_BM);
                par ^= 1; i = inx; }
            __syncthreads();
#undef IDX_ID
        }
#if defined(PROBE_PHASE_TIME) && PROBE_PHASE_TIME == 1
        tpb_ = clock64();
#endif
#ifdef PROBE_TIME
        if (blockIdx.x == 0 && F.tid == 0) { LAS unsigned long long* TA = (LAS unsigned long long*)(F.lds + EXTRA_OFF + 6144); float tot = 0.f; for (int k = 0; k < 6; ++k) tot += (float)TA[k];
            ((float*)(w + WS_MOD))[2 * 6 * DM] = floorf((float)TA[PROBE_TIME] / tot * 20.f + 0.5f) * 0.05f; }
#endif
        if (BOTH(3)) GRID_BAR();
    }
    for (int rep_ = 0; rep_ < DUPN(4); ++rep_) if (IN(4)) { WSP(w);
#ifdef PROBE_DELAY4
        for (int d_ = 0; d_ < 10; ++d_) __builtin_amdgcn_s_sleep(127);
#endif
#if defined(PROBE_PHASE_TIME) && PROBE_PHASE_TIME == 2
        tpa_ = clock64();
#endif
        for (int it = F.vcu; it < 2 * NHEAD * 16; it += F.G) { const int bh = it >> 4, p = it & 15;
            att::dsa_block(F, bh >> 3, bh & 7, 31 - p, SEGP(w, 3), SEGP(w, 4), SEGP(w, 5), DUPOUT(4, SEGP(w, 3)), (const u64*)(w + WS_BM), args.in[9 + zq]);
            att::dsa_block(F, bh >> 3, bh & 7, p, SEGP(w, 3), SEGP(w, 4), SEGP(w, 5), DUPOUT(4, SEGP(w, 3)), (const u64*)(w + WS_BM), args.in[9 + zq]); }
#if defined(PROBE_PHASE_TIME) && PROBE_PHASE_TIME == 2
        tpb_ = clock64();
#endif
        if (BOTH(4)) GRID_BAR();
    }
    for (int rep_ = 0; rep_ < DUPN(5); ++rep_) if (IN(5)) { WSP(w);
        pg8::Gemm g{SEGP(w, 0), (bf16*)(w + WS_WOSB), SEGP(w, 3), (bf16*)(w + WS_WODS), WATT}; pg8::TileOrder S; S.init(MROWS / 256, DM / 256, 2, F.G, (int)blockIdx.x);
        pg8::EpiMerged E{(const unsigned char*)out, (bf16*)(w + WS_H)};
        pg8::gemm_phase<pg8::EpiMerged, pg8::TileOrder, true, true>(F.lds + RING_OFF, g, S, E, F.tid, GEMM_TSTAT);
        if (BOTH(5)) GRID_BAR();
    }
    for (int rep_ = 0; rep_ < DUPN(6); ++rep_) if (IN(6)) { WSP(w);
        pg8::Gemm g{(bf16*)(w + WS_H), (bf16*)(w + WS_WOUT), (bf16*)(w + WS_H), (bf16*)(w + WS_WOUT), DM}; pg8::TileOrder S; S.init(MROWS / 256, DM / 256, 1, F.G, (int)blockIdx.x);
        pg8::EpiDelta<true> E{(bf16*)(w + WS_D1), MODP(w) + 2 * DM, 6 * DM};
        pg8::gemm_phase<pg8::EpiDelta<true>, pg8::TileOrder, true, true>(F.lds + RING_OFF, g, S, E, F.tid, GEMM_TSTAT);
        if (BOTH(6)) GRID_BAR();
    }
    for (int rep_ = 0; rep_ < DUPN(7); ++rep_) if (IN(7)) { WSP(w); norm_mod_rows<2>(F, (const bf16*)(w + WS_D1), nullptr, (bf16*)(w + WS_H), nullptr, (float*)(w + WS_SA), args.in[10 + zq], MODP(w) + 3 * DM, MODP(w) + 4 * DM); if (BOTH(7)) GRID_BAR(); }
    for (int rep_ = 0; rep_ < DUPN(8); ++rep_) if (IN(8)) { WSP(w);
        pg8::Gemm g{(bf16*)(w + WS_H), (bf16*)(w + WS_WGU), (bf16*)(w + WS_H), (bf16*)(w + WS_WGU), DM / 2}; pg8::TileOrder S; S.init(MROWS / 256, 2 * FF / 256, 1, F.G, (int)blockIdx.x);
        pg8::EpiGU<true> E{(bf16*)(w + WS_ACT), (float*)(w + WS_GHALO), (float*)(w + WS_GDEF), (float*)(w + WS_UDEF), args.in[13 + zq], args.in[14 + zq], (const float*)(w + WS_SA)};
        pg8::gemm_phase<pg8::EpiGU<true>, pg8::TileOrder, true, true, false, true>(F.lds + RING_OFF, g, S, E, F.tid, GEMM_TSTAT);
        if (BOTH(8)) GRID_BAR();
    }
    for (int rep_ = 0; rep_ < DUPN(9); ++rep_) if (IN(9)) { WSP(w); conv_fixup(F, (const float*)(w + WS_GHALO), (const float*)(w + WS_GDEF), (const float*)(w + WS_UDEF), args.in[13 + zq], args.in[14 + zq], (bf16*)(w + WS_ACT)); if (BOTH(9)) GRID_BAR(); }
#ifndef PROBE_ZERO_FFN
    for (int rep_ = 0; rep_ < DUPN(10); ++rep_) if (IN(10)) { WSP(w);
        pg8::Gemm g{(bf16*)(w + WS_ACT), (bf16*)(w + WS_WDN), (bf16*)(w + WS_ACT), (bf16*)(w + WS_WDN), FF}; pg8::TileOrder S; S.init(MROWS / 256, DM / 256, 1, F.G, (int)blockIdx.x);
        pg8::EpiDelta<false> E{(bf16*)(w + WS_H), MODP(w) + 5 * DM, 6 * DM};
        pg8::gemm_phase<pg8::EpiDelta<false>, pg8::TileOrder, true, true>(F.lds + RING_OFF, g, S, E, F.tid, GEMM_TSTAT);
        if (BOTH(10)) GRID_BAR();
    }
#endif
    if (IN(11)) { int zq = 0; asm volatile("" : "+s"(zq)); FRAME(F); norm_final_rows(F, (const bf16*)(ws + WS_D1), (const bf16*)(ws + WS_H), out, args.in[16 + zq]);
#ifdef PROBE_PHASE_TIME
        { if (blockIdx.x == 0 && F.tid == 0) ((float*)(ws + WS_MOD))[2 * 6 * DM + 2] = floorf((float)(tpb_ - tpa_) / (float)(clock64() - tk0_) * 40.f + 0.5f) * 0.025f;
          GRID_BAR();
          const float m = 1.0f + ((const float*)(ws + WS_MOD))[2 * 6 * DM + 2]; const int gw = F.vcu * NWAVES + F.wave, NGW = F.G * NWAVES;
          for (int row = gw; row < MROWS; row += NGW) { GAS f32x4* xr = (GAS f32x4*)(out + (size_t)row * DM) + F.lane; for (int j = 0; j < 8; ++j) xr[64 * j] = xr[64 * j] * m; } }
#endif
#ifdef PROBE_GEMM_TIME
        { LAS unsigned long long* ts_ = (LAS unsigned long long*)(F.lds + EXTRA_OFF + 4096) + 2 * PROBE_GEMM_TIME;
          if (blockIdx.x == 0 && F.tid == 0) ((float*)(ws + WS_MOD))[2 * 6 * DM + 1] = floorf((float)ts_[0] / (float)ts_[1] * 50.f + 0.5f) * 0.02f;
          GRID_BAR();
          const float m = 1.0f + ((const float*)(ws + WS_MOD))[2 * 6 * DM + 1]; const int gw = F.vcu * NWAVES + F.wave, NGW = F.G * NWAVES;
          for (int row = gw; row < MROWS; row += NGW) { GAS f32x4* xr = (GAS f32x4*)(out + (size_t)row * DM) + F.lane; for (int j = 0; j < 8; ++j) xr[64 * j] = xr[64 * j] * m; } }
#endif
#ifdef PROBE_TIME
        { const float m = 1.0f + ((const float*)(ws + WS_MOD))[2 * 6 * DM]; __syncthreads(); VM_WAIT(); const int gw = F.vcu * NWAVES + F.wave, NGW = F.G * NWAVES;
          for (int row = gw; row < MROWS; row += NGW) { GAS f32x4* xr = (GAS f32x4*)(out + (size_t)row * DM) + F.lane; for (int j = 0; j < 8; ++j) xr[64 * j] = xr[64 * j] * m; } }
#endif
    }
#undef IN
#undef BOTH
#undef GRID_BAR
}

extern "C" void kernel_launch(void* const* d_in, const int* in_sizes, int n_in, void* d_out, int out_size, void* d_ws, size_t ws_size, hipStream_t stream) {
    static int grid = 0;
    if (grid == 0) {
        if (n_in != 17 || in_sizes[0] != MROWS * DM || out_size != MROWS * DM || ws_size < WS_END) { fprintf(stderr, "kernel_launch: unexpected shapes (n_in %d, in0 %d, out %d, ws %zu); nothing launched\n", n_in, n_in > 0 ? in_sizes[0] : -1, out_size, ws_size); grid = -1; return; }
        int dev = 0, cus = 0, per_cu = 0;
        if (hipGetDevice(&dev) != hipSuccess || hipDeviceGetAttribute(&cus, hipDeviceAttributeMultiprocessorCount, dev) != hipSuccess) { grid = -1; return; }
        if (hipFuncSetAttribute((const void*)mk_fwd, hipFuncAttributeMaxDynamicSharedMemorySize, LDS_BYTES) != hipSuccess) { fprintf(stderr, "kernel_launch: hipFuncSetAttribute failed\n"); grid = -1; return; }
        if (hipOccupancyMaxActiveBlocksPerMultiprocessor(&per_cu, (const void*)mk_fwd, NWAVES * 64, LDS_BYTES) != hipSuccess || per_cu < 1)
            fprintf(stderr, "kernel_launch: note: occupancy query reports %d workgroups per CU\n", per_cu);
        (void)hipGetLastError();
        grid = cus;
    }
    if (grid < 0) return;
    if (hipMemsetAsync((char*)d_ws + WS_CTL, 0, ZERO_BYTES, stream) != hipSuccess) { fprintf(stderr, "kernel_launch: memset failed\n"); return; }
    Args a{};
    for (int i = 0; i < 17; ++i) a.in[i] = (const float*)d_in[i];
    a.out = (float*)d_out; a.ws = (unsigned char*)d_ws;
    for (int li = 0; li < N_LAUNCHES; ++li) {
        a.ph_lo = (N_LAUNCHES == 1) ? 0 : li; a.ph_hi = (N_LAUNCHES == 1) ? NPH : li + 1;
        hipLaunchKernelGGL(mk_fwd, dim3(grid), dim3(NWAVES * 64), LDS_BYTES, stream, a);
        const hipError_t le = hipPeekAtLastError();
        if (le != hipSuccess) { fprintf(stderr, "kernel_launch: launch %d failed: %s\n", li, hipGetErrorName(le)); break; }
    }
}
```

```cpp
#include <hip/hip_runtime.h>
#include <cstdio>
#include <cstdint>

#define WEIGHTS_ALL_IN_P0 1
#ifndef MK_N_LAUNCHES
#define MK_N_LAUNCHES 1
#endif

namespace pg8 {
#define PG8_LAS __attribute__((address_space(3)))
typedef unsigned short bf16_t;
typedef short bf16x8 __attribute__((ext_vector_type(8)));
typedef float f32x4 __attribute__((ext_vector_type(4)));
typedef unsigned u32x4 __attribute__((ext_vector_type(4)));
typedef unsigned u32x2 __attribute__((ext_vector_type(2)));
constexpr int BM = 256, BK = 64, HALF = 128, HTB = HALF * BK * 2  , STAGE_BYTES = 8 * HTB, NXCD = 8, WGM = 8;

__host__ __device__ __forceinline__ int lds_byte(int r, int c) { const int st = (r >> 4) * 2 + (c >> 5), rr = r & 15, cc = c & 31, ob = rr * 64 + cc * 2; return st * 1024 + (ob ^ (((ob >> 9) & 1) << 5)); }
__host__ __device__ __forceinline__ void stage_rc(int b, int& R, int& C) { const int st = b / 1024, sb = b % 1024, swz = sb ^ (((sb >> 9) & 1) << 5); R = (st >> 1) * 16 + swz / 64; C = (st & 1) * 32 + (swz % 64) / 2; }
__host__ __device__ __forceinline__ int perm32(int rho) { const int n = rho >> 4, i = rho & 15; return 8 * (i >> 2) + 4 * n + (i & 3); }

struct Unit { int pm, pn, part; };
struct Gemm { const bf16_t* A; const bf16_t* Bt; const bf16_t* A2; const bf16_t* Bt2; int K; };

struct TileOrder {
    int nM, nN, nwg, G, c, parts;
    __host__ __device__ void init(int nM_, int nN_, int parts_, int G_, int c_) { nM = nM_; nN = nN_; nwg = nM * nN; G = G_; c = c_; parts = parts_; }
    __host__ __device__ bool next(int i, Unit& u) const {
        const int ti = (parts == 2) ? (i >> 1) : i; u.part = (parts == 2) ? (i & 1) : 0;
        const long L = (long)ti * G + c; if (L >= nwg) return false;
        int wgid = (int)L; { const int q = nwg / NXCD, r = nwg % NXCD, xcd = wgid % NXCD, off = wgid / NXCD; wgid = (xcd < r ? xcd * (q + 1) : r * (q + 1) + (xcd - r) * q) + off; }
        const int nig = WGM * nN, gid = wgid / nig, fm = gid * WGM, gsz = (nM - fm) < WGM ? (nM - fm) : WGM;
        u.pm = fm + ((wgid % nig) % gsz); u.pn = (wgid % nig) / gsz; return true;
    }
};

typedef _Float16 h16x2 __attribute__((ext_vector_type(2)));
typedef _Float16 h16x8 __attribute__((ext_vector_type(8)));
typedef int i32x8 __attribute__((ext_vector_type(8)));
constexpr float MRG_QS = 127.0f / 2.5f;
constexpr float WQS8 = 127.0f * 45.254834f / 4.5f;
typedef int i32x4q __attribute__((ext_vector_type(4)));
typedef float f32x2c __attribute__((ext_vector_type(2)));
__device__ __forceinline__ unsigned cvt_pk_bf16(float lo, float hi) { return __builtin_bit_cast(unsigned, __builtin_convertvector((f32x2c){lo, hi}, h16x2)); }
__device__ __forceinline__ float bf_lo(unsigned w) { return (float)__builtin_bit_cast(h16x2, w)[0]; }
__device__ __forceinline__ float bf_hi(unsigned w) { return (float)__builtin_bit_cast(h16x2, w)[1]; }
__device__ __forceinline__ float sigmoidf_fast(float x) { return __builtin_amdgcn_rcpf(1.0f + __builtin_amdgcn_exp2f(-1.4426950408889634f * x)); }
__device__ __forceinline__ u32x4 pack8(const f32x4& v0, const f32x4& v1) { u32x4 w; w.x = cvt_pk_bf16(v0[0], v0[1]); w.y = cvt_pk_bf16(v0[2], v0[3]); w.z = cvt_pk_bf16(v1[0], v1[1]); w.w = cvt_pk_bf16(v1[2], v1[3]); return w; }

typedef unsigned u32x2e __attribute__((ext_vector_type(2)));
struct EpiIn {
    static constexpr bool PERM = true;
    bf16_t* seg0; size_t seg_stride; unsigned char* gates; bf16_t* kix; float* wix; float wscale;
    __device__ __forceinline__ bool keep(const Unit&) const { return false; }
    __device__ __forceinline__ void operator()(f32x4 (&acc)[2][2][4][2], const Unit& u, int wr, int wc, int fr, int fq) const {
        const int row0 = u.pm * BM + wr * 64 + fr;
        if (u.pn < 44) {
            const bool gate = u.pn >= 28;
            bf16_t* base = seg0 + (size_t)((u.pn >> 2) == 2 ? 6 : (u.pn >> 2)) * seg_stride;
            const int col0 = (gate ? (u.pn - 28) * BM : (u.pn & 3) * BM) + wc * 32 + 8 * fq;
#pragma unroll
            for (int ai = 0; ai < 2; ++ai)
#pragma unroll
                for (int m = 0; m < 4; ++m) { const size_t row = (size_t)(row0 + ai * HALF + m * 16);
#pragma unroll
                    for (int bj = 0; bj < 2; ++bj) { f32x4 v0 = acc[ai][bj][m][0], v1 = acc[ai][bj][m][1];
                        if (gate) {
                            unsigned lo = 0u, hi = 0u;
#pragma unroll
                            for (int e = 0; e < 4; ++e) { lo |= (unsigned)(sigmoidf_fast(v0[e]) * 255.f + 0.5f) << (8 * e); hi |= (unsigned)(sigmoidf_fast(v1[e]) * 255.f + 0.5f) << (8 * e); }
                            u32x2e w2; w2.x = lo; w2.y = hi; *(u32x2e*)(gates + row * 4096 + col0 + bj * HALF) = w2; }
                        else *(u32x4*)(base + row * 1024 + col0 + bj * HALF) = pack8(v0, v1); } }
        } else {
#pragma unroll
            for (int ai = 0; ai < 2; ++ai)
#pragma unroll
                for (int m = 0; m < 4; ++m) { const size_t row = (size_t)(row0 + ai * HALF + m * 16); const f32x4 v0 = acc[ai][0][m][0], v1 = acc[ai][0][m][1];
                    if (wc < 2) *(u32x4*)(kix + (row >> 5) * 2048 + ((wc * 4 + fq) * 32 + (row & 31)) * 8) = pack8(v0, v1);
                    else if (wc == 2 && fq < 2) { float* p = wix + row * 16 + 8 * fq; *(f32x4*)p = v0 * wscale; *(f32x4*)(p + 4) = v1 * wscale; } }
        }
    }
};

struct EpiGate {
    static constexpr bool PERM = true;
    unsigned char* gates; const float* sa; bf16_t* vds; size_t vstride;
    __device__ __forceinline__ bool keep(const Unit&) const { return false; }
    __device__ __forceinline__ void operator()(f32x4 (&acc)[2][2][4][2], const Unit& u, int wr, int wc, int fr, int fq) const {
        const bool isv = u.pn >= 16;
        unsigned char* base = isv ? (unsigned char*)(vds + (size_t)((u.pn - 16) >> 2) * vstride + (size_t)((u.pn - 16) & 3) * BM) : gates + (size_t)u.pn * BM;
        const unsigned pitch = isv ? 2048u : 4096u, esz = isv ? 2u : 1u;
        const unsigned lo_ = (unsigned)(u.pm * BM + wr * 64 + fr) * pitch + (unsigned)(wc * 32 + 8 * fq) * esz;
#pragma unroll
        for (int ai = 0; ai < 2; ++ai)
#pragma unroll
            for (int m = 0; m < 4; ++m)
#pragma unroll
                for (int bj = 0; bj < 2; ++bj) { const float sr = sa[u.pm * BM + ai * HALF + wr * 64 + m * 16 + fr];
                    const i32x4q i0 = __builtin_bit_cast(i32x4q, acc[ai][bj][m][0]), i1 = __builtin_bit_cast(i32x4q, acc[ai][bj][m][1]);
                    const f32x4 v0 = (f32x4){(float)i0[0], (float)i0[1], (float)i0[2], (float)i0[3]} * sr, v1 = (f32x4){(float)i1[0], (float)i1[1], (float)i1[2], (float)i1[3]} * sr;
                    unsigned char* p = base + (lo_ + (unsigned)(ai * HALF + m * 16) * pitch + (unsigned)(bj * HALF) * esz);
                    if (isv) *(u32x4*)p = pack8(v0, v1);
                    else { unsigned lo = 0u, hi = 0u;
#pragma unroll
                        for (int e = 0; e < 4; ++e) { lo |= (unsigned)(sigmoidf_fast(v0[e]) * 255.f + 0.5f) << (8 * e); hi |= (unsigned)(sigmoidf_fast(v1[e]) * 255.f + 0.5f) << (8 * e); }
                        u32x2e w2; w2.x = lo; w2.y = hi; *(u32x2e*)p = w2; } }
    }
};

struct EpiMerged {
    static constexpr bool PERM = true;
    const unsigned char* gates; bf16_t* out;
    __device__ __forceinline__ bool keep(const Unit& u) const { return u.part == 0; }
    __device__ __forceinline__ void operator()(f32x4 (&acc)[2][2][4][2], const Unit& u, int wr, int wc, int fr, int fq) const {
        const int row0 = u.pm * BM + wr * 64 + fr, col0 = u.pn * BM + wc * 32 + 8 * fq;
        const int psel = (u.part == 0) ? 0 : 2048;
#pragma unroll
        for (int ai = 0; ai < 2; ++ai) {
#pragma unroll
          for (int mh = 0; mh < 2; ++mh) {
            u32x2e gs[4][2], gd[4][2];
#pragma unroll
            for (int m = 2 * mh; m < 2 * mh + 2; ++m)
#pragma unroll
                for (int bj = 0; bj < 2; ++bj) { const size_t off = (size_t)(row0 + ai * HALF + m * 16) * 4096 + col0 + bj * HALF; gd[m][bj] = *(const u32x2e*)(gates + off + 2048);
                    gs[m][bj] = *(const u32x2e*)(gates + off + psel); }
            asm volatile("" ::: "memory");
#pragma unroll
            for (int m = 2 * mh; m < 2 * mh + 2; ++m) { const size_t row = (size_t)(row0 + ai * HALF + m * 16);
#pragma unroll
                for (int bj = 0; bj < 2; ++bj) { const int col = col0 + bj * HALF;
                    float fs[8], fd[8];
#pragma unroll
                    for (int e = 0; e < 4; ++e) { constexpr float Q = 1.0f / 255.0f;
                        fs[e] = (float)((gs[m][bj].x >> (8 * e)) & 0xffu) * Q; fs[4 + e] = (float)((gs[m][bj].y >> (8 * e)) & 0xffu) * Q;
                        fd[e] = fmaxf((float)((gd[m][bj].x >> (8 * e)) & 0xffu) * Q, 1e-20f); fd[4 + e] = fmaxf((float)((gd[m][bj].y >> (8 * e)) & 0xffu) * Q, 1e-20f); }
                    f32x4 v0 = acc[ai][bj][m][0], v1 = acc[ai][bj][m][1];
                    if (u.part == 0) {
#pragma unroll
                        for (int e = 0; e < 4; ++e) { v0[e] *= fs[e] * __builtin_amdgcn_rcpf(fd[e]); v1[e] *= fs[4 + e] * __builtin_amdgcn_rcpf(fd[4 + e]); }
                        acc[ai][bj][m][0] = v0; acc[ai][bj][m][1] = v1;
                    } else {
#pragma unroll
                        for (int e = 0; e < 4; ++e) { v0[e] *= fd[e]; v1[e] *= fd[4 + e]; }
                        {   unsigned lo = 0u, hi = 0u;
#pragma unroll
                            for (int e = 0; e < 4; ++e) { int qa = (int)rintf(v0[e] * MRG_QS), qb = (int)rintf(v1[e] * MRG_QS); qa = qa < -127 ? -127 : (qa > 127 ? 127 : qa); qb = qb < -127 ? -127 : (qb > 127 ? 127 : qb);
                                lo |= ((unsigned)qa & 0xffu) << (8 * e); hi |= ((unsigned)qb & 0xffu) << (8 * e); }
                            u32x2e w2; w2.x = lo; w2.y = hi; *(u32x2e*)((unsigned char*)out + row * 2048 + col) = w2; }
                    } } }
            asm volatile("" ::: "memory");
          }
        }
    }
};

struct EpiResid {
    static constexpr bool PERM = false;
    const float* base; float* out; const float* gt;
    int gstride;
    __device__ __forceinline__ bool keep(const Unit&) const { return false; }
    __device__ __forceinline__ void operator()(f32x4 (&acc)[2][2][4][2], const Unit& u, int wr, int wc, int fr, int fq) const {
        const int row0 = u.pm * BM + wr * 64 + fr, col0 = u.pn * BM + wc * 32 + 4 * fq;
        const float* g = gt + (size_t)(u.pm >> 5) * gstride;
#pragma unroll
        for (int bj = 0; bj < 2; ++bj) {
#pragma unroll
            for (int n = 0; n < 2; ++n) { f32x4 bs[2][4]; const f32x4 gv = *(const f32x4*)(g + col0 + bj * HALF + n * 16);
#pragma unroll
                for (int ai = 0; ai < 2; ++ai)
#pragma unroll
                    for (int m = 0; m < 4; ++m) bs[ai][m] = *(const f32x4*)(base + (size_t)(row0 + ai * HALF + m * 16) * 2048 + col0 + bj * HALF + n * 16);
                asm volatile("" ::: "memory");
#pragma unroll
                for (int ai = 0; ai < 2; ++ai)
#pragma unroll
                    for (int m = 0; m < 4; ++m) *(f32x4*)(out + (size_t)(row0 + ai * HALF + m * 16) * 2048 + col0 + bj * HALF + n * 16) = bs[ai][m] + gv * acc[ai][bj][m][n];
                asm volatile("" ::: "memory"); }
        }
    }
};

template <bool ACC, bool I8 = false> struct EpiDelta {
    static constexpr bool PERM = true;
    bf16_t* out; const float* gt; int gstride;
    __device__ __forceinline__ bool keep(const Unit&) const { return false; }
    __device__ __forceinline__ void operator()(f32x4 (&acc)[2][2][4][2], const Unit& u, int wr, int wc, int fr, int fq) const {
        const int row0 = u.pm * BM + wr * 64 + fr, col0 = u.pn * BM + wc * 32 + 8 * fq;
        const float* g = gt + (size_t)(u.pm >> 5) * gstride;
#pragma unroll
        for (int bj = 0; bj < 2; ++bj) { const f32x4 g0 = *(const f32x4*)(g + col0 + bj * HALF), g1 = *(const f32x4*)(g + col0 + bj * HALF + 4);
            u32x4 old[2][4];
            if (ACC) {
#pragma unroll
                for (int ai = 0; ai < 2; ++ai)
#pragma unroll
                    for (int m = 0; m < 4; ++m) old[ai][m] = *(const u32x4*)(out + (size_t)(row0 + ai * HALF + m * 16) * 2048 + col0 + bj * HALF);
                asm volatile("" ::: "memory"); }
#pragma unroll
            for (int ai = 0; ai < 2; ++ai)
#pragma unroll
                for (int m = 0; m < 4; ++m) { f32x4 a0_ = acc[ai][bj][m][0], a1_ = acc[ai][bj][m][1];
                    if (I8) { const i32x4q i0 = __builtin_bit_cast(i32x4q, a0_), i1 = __builtin_bit_cast(i32x4q, a1_); constexpr float DQ = 1.0f / (MRG_QS * WQS8);
                        a0_ = (f32x4){(float)i0[0], (float)i0[1], (float)i0[2], (float)i0[3]} * DQ; a1_ = (f32x4){(float)i1[0], (float)i1[1], (float)i1[2], (float)i1[3]} * DQ; }
                    f32x4 v0 = g0 * a0_, v1 = g1 * a1_;
                    if (ACC) { const u32x4 o = old[ai][m]; v0 += (f32x4){bf_lo(o.x), bf_hi(o.x), bf_lo(o.y), bf_hi(o.y)}; v1 += (f32x4){bf_lo(o.z), bf_hi(o.z), bf_lo(o.w), bf_hi(o.w)}; }
                    *(u32x4*)(out + (size_t)(row0 + ai * HALF + m * 16) * 2048 + col0 + bj * HALF) = pack8(v0, v1); }
            asm volatile("" ::: "memory"); }
    }
};

__device__ __forceinline__ float dpp_ror1(float v) { return __int_as_float(__builtin_amdgcn_update_dpp(0, __float_as_int(v), 0x121, 0xf, 0xf, false)); }
__device__ __forceinline__ float dpp_ror2(float v) { return __int_as_float(__builtin_amdgcn_update_dpp(0, __float_as_int(v), 0x122, 0xf, 0xf, false)); }
template <bool I8 = false> struct EpiGU {
    static constexpr bool PERM = true;
    bf16_t* act; float* ghalo; float* gdef; float* udef; const float* convw; const float* convb;
    const float* sa;
    __device__ __forceinline__ bool keep(const Unit&) const { return false; }
    __device__ __forceinline__ void operator()(f32x4 (&acc)[2][2][4][2], const Unit& u, int wr, int wc, int fr, int fq) const {
        constexpr int FF = 5632;
        if (I8) {
#pragma unroll
            for (int ai = 0; ai < 2; ++ai)
#pragma unroll
                for (int m = 0; m < 4; ++m) { const float sr = sa[u.pm * BM + ai * HALF + wr * 64 + m * 16 + fr];
#pragma unroll
                    for (int bj = 0; bj < 2; ++bj)
#pragma unroll
                        for (int n = 0; n < 2; ++n) { const i32x4q iv = __builtin_bit_cast(i32x4q, acc[ai][bj][m][n]); acc[ai][bj][m][n] = (f32x4){(float)iv[0], (float)iv[1], (float)iv[2], (float)iv[3]} * sr; } } }
        const int f0 = u.pn * HALF + wc * 32 + 8 * fq;
        f32x4 w0[2], w1[2], w2[2], cb[2];
#pragma unroll
        for (int n = 0; n < 2; ++n) { w0[n] = *(const f32x4*)(convw + f0 + 4 * n); w1[n] = *(const f32x4*)(convw + FF + f0 + 4 * n); w2[n] = *(const f32x4*)(convw + 2 * FF + f0 + 4 * n); cb[n] = *(const f32x4*)(convb + f0 + 4 * n); }
#pragma unroll
        for (int ai = 0; ai < 2; ++ai) {
            const int rb = u.pm * BM + ai * HALF + wr * 64, blk = rb >> 6;
#pragma unroll
            for (int m = 0; m < 4; ++m) {
                f32x4 res[2];
#pragma unroll
                for (int n = 0; n < 2; ++n)
#pragma unroll
                    for (int e = 0; e < 4; ++e) {
                        const float g = acc[ai][0][m][n][e], gp = (m > 0) ? acc[ai][0][m - 1][n][e] : 0.f;
                        const float r1a = dpp_ror1(g), r1b = dpp_ror1(gp), r2a = dpp_ror2(g), r2b = dpp_ror2(gp);
                        const float g1 = (fr == 0) ? r1b : r1a, g2 = (fr < 2) ? r2b : r2a;
                        const float a = cb[n][e] + w0[n][e] * g2 + w1[n][e] * g1 + w2[n][e] * g;
                        res[n][e] = a * sigmoidf_fast(a) * acc[ai][1][m][n][e];
                    }
                const int row = rb + m * 16 + fr;
                if (m == 0 && fr < 2) {
                    float* gd = gdef + (size_t)(blk * 2 + fr) * FF + f0; float* ud = udef + (size_t)(blk * 2 + fr) * FF + f0;
                    *(f32x4*)gd = acc[ai][0][0][0]; *(f32x4*)(gd + 4) = acc[ai][0][0][1]; *(f32x4*)ud = acc[ai][1][0][0]; *(f32x4*)(ud + 4) = acc[ai][1][0][1];
                } else {
                    *(u32x4*)(act + (size_t)row * FF + f0) = pack8(res[0], res[1]);
                }
                if (m == 3 && fr >= 14) { float* gh = ghalo + (size_t)(blk * 2 + (fr - 14)) * FF + f0; *(f32x4*)gh = acc[ai][0][3][0]; *(f32x4*)(gh + 4) = acc[ai][0][3][1]; }
            }
        }
    }
};

template <class Epi, class Sched, bool ALIGN_EPI = false, bool SP2 = false, bool FP8 = false, bool I8 = false>
__device__ __forceinline__ void gemm_phase(PG8_LAS unsigned char* lds, const Gemm g, const Sched& S, const Epi& E, const int tid, PG8_LAS unsigned long long* tstat = nullptr) {
#ifdef PROBE_GEMM_TIME
    const unsigned long long tph0_ = clock64();
#endif
    const int wid = __builtin_amdgcn_readfirstlane(tid >> 6), lane = tid & 63, wr = wid >> 2, wc = wid & 3, fr = lane & 15, fq = lane >> 4;
    const int K = g.K, nt = K / BK;
    unsigned voffA[2], voffB[2];
#pragma unroll
    for (int i = 0; i < 2; ++i) { int R, C; stage_rc(tid * 16 + i * 8192, R, C); const int Rb = Epi::PERM ? ((R & ~31) + perm32(R & 31)) : R;
        voffA[i] = (unsigned)(R * K + C) * 2u; voffB[i] = (unsigned)(Rb * K + C) * 2u; }
    const size_t rstep64 = (size_t)64 * K * 2;
    const size_t kstep = (size_t)(BK * 2);
    const size_t hstep = (size_t)HALF * K * 2;
    const size_t tstep = 2 * hstep;
    const unsigned ldsw = (unsigned)wid * 1024u;
    const int aoff = lds_byte(wr * 64 + fr, fq * 8), boff = lds_byte(wc * 32 + fr, fq * 8);
#define PG8_SA(b, h) (((b) * 2 + (h)) * HTB)
#define PG8_PA(u) ((const char*)((u).part ? g.A2 : g.A) + (size_t)(u).pm * tstep)
#define PG8_PB(u) ((const char*)((u).part ? g.Bt2 : g.Bt) + (size_t)(u).pn * tstep)
#define PG8_SB(b, h) ((4 + (b) * 2 + (h)) * HTB)
#define PG8_STAGE(bufoff, gbase, voff) do { _Pragma("unroll") for (int _i = 0; _i < 2; ++_i)   \
        __builtin_amdgcn_global_load_lds((const unsigned*)((const char*)(gbase) + (size_t)_i * rstep64 + (voff)[0]), (PG8_LAS unsigned*)(lds + (bufoff) + ldsw + _i * 8192), 16, 0, 0); } while (0)
#define PG8_LDA(dst, b, h) do { _Pragma("unroll") for (int m = 0; m < 4; ++m) _Pragma("unroll") for (int k = 0; k < 2; ++k) dst[m][k] = *(const PG8_LAS bf16x8*)(lds + PG8_SA(b, h) + aoff + m * 2048 + k * 1024); } while (0)
#define PG8_LDB(dst, b, h) do { _Pragma("unroll") for (int n = 0; n < 2; ++n) _Pragma("unroll") for (int k = 0; k < 2; ++k) dst[n][k] = *(const PG8_LAS bf16x8*)(lds + PG8_SB(b, h) + boff + n * 2048 + k * 1024); } while (0)
#define PG8_MMA(ai, bj, At, Bt) do { __builtin_amdgcn_s_setprio(1); \
        if constexpr (FP8) { _Pragma("unroll") for (int m = 0; m < 4; ++m) _Pragma("unroll") for (int n = 0; n < 2; ++n) { \
            const u32x4 b0_ = __builtin_bit_cast(u32x4, Bt[n][0]), b1_ = __builtin_bit_cast(u32x4, Bt[n][1]), a0_ = __builtin_bit_cast(u32x4, At[m][0]), a1_ = __builtin_bit_cast(u32x4, At[m][1]); \
            const i32x8 bo_ = {(int)b0_.x, (int)b0_.y, (int)b0_.z, (int)b0_.w, (int)b1_.x, (int)b1_.y, (int)b1_.z, (int)b1_.w}, ao_ = {(int)a0_.x, (int)a0_.y, (int)a0_.z, (int)a0_.w, (int)a1_.x, (int)a1_.y, (int)a1_.z, (int)a1_.w}; \
            acc[ai][bj][m][n] = __builtin_amdgcn_mfma_scale_f32_16x16x128_f8f6f4(bo_, ao_, acc[ai][bj][m][n], 0, 0, 0, 0x7f7f7f7f, 0, 0x7f7f7f7f); } } \
        else if constexpr (I8) {   \
            _Pragma("unroll") for (int m = 0; m < 4; ++m) _Pragma("unroll") for (int n = 0; n < 2; ++n) _Pragma("unroll") for (int k = 0; k < 2; ++k) \
            acc[ai][bj][m][n] = __builtin_bit_cast(f32x4, __builtin_amdgcn_mfma_i32_16x16x64_i8(__builtin_bit_cast(i32x4q, Bt[n][k]), __builtin_bit_cast(i32x4q, At[m][k]), __builtin_bit_cast(i32x4q, acc[ai][bj][m][n]), 0, 0, 0)); } \
        else { _Pragma("unroll") for (int m = 0; m < 4; ++m) _Pragma("unroll") for (int n = 0; n < 2; ++n) _Pragma("unroll") for (int k = 0; k < 2; ++k) \
            acc[ai][bj][m][n] = __builtin_amdgcn_mfma_f32_16x16x32_f16(__builtin_bit_cast(h16x8, Bt[n][k]), __builtin_bit_cast(h16x8, At[m][k]), acc[ai][bj][m][n], 0, 0, 0); } \
        __builtin_amdgcn_s_setprio(0); } while (0)
#define PG8_WAIT_V(n) asm volatile("s_waitcnt vmcnt(" #n ")" ::: "memory")
#define PG8_WAIT_L(n) asm volatile("s_waitcnt lgkmcnt(" #n ")" ::: "memory")
#define PG8_BAR __builtin_amdgcn_s_barrier()
#define PG8_SCHED __builtin_amdgcn_sched_barrier(0)
    Unit cur, nxt; int ui = 0;
    if (!S.next(0, cur)) return;
    f32x4 acc[2][2][4][2];
#pragma unroll
    for (int a = 0; a < 2; ++a)
#pragma unroll
        for (int b = 0; b < 2; ++b)
#pragma unroll
            for (int m = 0; m < 4; ++m)
#pragma unroll
                for (int n = 0; n < 2; ++n) acc[a][b][m][n] = (f32x4){0.f, 0.f, 0.f, 0.f};
    bf16x8 At[4][2], B0[2][2], B1[2][2];
    const char* cA = PG8_PA(cur); const char* cB = PG8_PB(cur);
    if constexpr (SP2) {
        PG8_STAGE(PG8_SB(0, 0), cB, voffB); PG8_STAGE(PG8_SB(0, 1), cB + hstep, voffB); PG8_STAGE(PG8_SA(0, 0), cA, voffA); PG8_STAGE(PG8_SA(0, 1), cA + hstep, voffA);
        if (wr == 1) PG8_BAR;
        PG8_WAIT_V(2); PG8_BAR;
        PG8_STAGE(PG8_SB(1, 0), cB + kstep, voffB); PG8_STAGE(PG8_SA(1, 0), cA + kstep, voffA); PG8_STAGE(PG8_SB(1, 1), cB + hstep + kstep, voffB);
        PG8_WAIT_V(6); PG8_BAR;
    } else {
        PG8_STAGE(PG8_SB(0, 0), cB, voffB); PG8_STAGE(PG8_SA(0, 0), cA, voffA); PG8_STAGE(PG8_SB(0, 1), cB + hstep, voffB); PG8_STAGE(PG8_SA(0, 1), cA + hstep, voffA);
        if (wr == 1) PG8_BAR;
        PG8_WAIT_V(4); PG8_BAR;
        PG8_STAGE(PG8_SB(1, 0), cB + kstep, voffB); PG8_STAGE(PG8_SA(1, 0), cA + kstep, voffA); PG8_STAGE(PG8_SB(1, 1), cB + hstep + kstep, voffB);
        PG8_WAIT_V(6); PG8_BAR;
    }
    for (;;) {
        const bool has_next = S.next(ui + 1, nxt);
        const char* nA = has_next ? PG8_PA(nxt) : cA; const char* nB = has_next ? PG8_PB(nxt) : cB;
        for (int t = 0; t < nt; t += 2) {
            const bool last = (t == nt - 2);
            const char* a1 = cA + (size_t)(t + 1) * kstep;
            const char* a2 = last ? nA : cA + (size_t)(t + 2) * kstep; const char* b2 = last ? nB : cB + (size_t)(t + 2) * kstep;
            const char* a3 = a2 + kstep; const char* b3 = b2 + kstep;
            if constexpr (SP2) {
            PG8_LDB(B0, 0, 0); PG8_LDB(B1, 0, 1); PG8_SCHED; PG8_LDA(At, 0, 0); PG8_STAGE(PG8_SA(1, 1), a1 + hstep, voffA);
            PG8_WAIT_V(8); PG8_WAIT_L(0); PG8_BAR; PG8_MMA(0, 0, At, B0); PG8_MMA(0, 1, At, B1); PG8_BAR; PG8_SCHED;
            PG8_LDA(At, 0, 1); PG8_STAGE(PG8_SB(0, 0), b2, voffB); PG8_STAGE(PG8_SB(0, 1), b2 + hstep, voffB); PG8_STAGE(PG8_SA(0, 0), a2, voffA);
            PG8_WAIT_V(8); PG8_WAIT_L(0); PG8_BAR; PG8_MMA(1, 0, At, B0); PG8_MMA(1, 1, At, B1); PG8_BAR; PG8_SCHED;
            PG8_LDB(B0, 1, 0); PG8_LDB(B1, 1, 1); PG8_SCHED; PG8_LDA(At, 1, 0); PG8_STAGE(PG8_SA(0, 1), a2 + hstep, voffA);
            PG8_WAIT_V(8); PG8_WAIT_L(0); PG8_BAR; PG8_MMA(0, 0, At, B0); PG8_MMA(0, 1, At, B1); PG8_BAR; PG8_SCHED;
            PG8_LDA(At, 1, 1); PG8_STAGE(PG8_SB(1, 0), b3, voffB); PG8_STAGE(PG8_SB(1, 1), b3 + hstep, voffB); PG8_STAGE(PG8_SA(1, 0), a3, voffA);
            PG8_WAIT_V(8); PG8_WAIT_L(0); PG8_BAR; PG8_MMA(1, 0, At, B0); PG8_MMA(1, 1, At, B1); PG8_BAR; PG8_SCHED;
            } else {
            PG8_LDB(B0, 0, 0); PG8_SCHED; PG8_LDA(At, 0, 0); PG8_STAGE(PG8_SA(1, 1), a1 + hstep, voffA);
            PG8_WAIT_L(8); PG8_BAR; PG8_WAIT_L(0); PG8_MMA(0, 0, At, B0); PG8_BAR; PG8_SCHED;
            PG8_LDB(B1, 0, 1); PG8_STAGE(PG8_SB(0, 0), b2, voffB);
            PG8_BAR; PG8_WAIT_L(0); PG8_MMA(0, 1, At, B1); PG8_BAR;
            PG8_LDA(At, 0, 1); PG8_STAGE(PG8_SA(0, 0), a2, voffA);
            PG8_BAR; PG8_WAIT_L(0); PG8_MMA(1, 0, At, B0); PG8_BAR; PG8_SCHED;
            PG8_STAGE(PG8_SB(0, 1), b2 + hstep, voffB);
            PG8_WAIT_V(6); PG8_BAR; PG8_MMA(1, 1, At, B1); PG8_BAR;
            PG8_LDB(B0, 1, 0); PG8_SCHED; PG8_LDA(At, 1, 0); PG8_STAGE(PG8_SA(0, 1), a2 + hstep, voffA);
            PG8_WAIT_L(8); PG8_BAR; PG8_WAIT_L(0); PG8_MMA(0, 0, At, B0); PG8_BAR; PG8_SCHED;
            PG8_LDB(B1, 1, 1); PG8_STAGE(PG8_SB(1, 0), b3, voffB);
            PG8_BAR; PG8_WAIT_L(0); PG8_MMA(0, 1, At, B1); PG8_BAR;
            PG8_LDA(At, 1, 1); PG8_STAGE(PG8_SA(1, 0), a3, voffA);
            PG8_BAR; PG8_WAIT_L(0); PG8_MMA(1, 0, At, B0); PG8_BAR; PG8_SCHED;
            PG8_STAGE(PG8_SB(1, 1), b3 + hstep, voffB);
            PG8_WAIT_V(6); PG8_BAR; PG8_MMA(1, 1, At, B1); PG8_BAR;
            }
        }
        if constexpr (ALIGN_EPI) { if (wr == 0) PG8_BAR; }

#ifdef PROBE_GEMM_TIME
        { const unsigned long long te0_ = clock64(); E(acc, cur, wr, wc, fr, fq); asm volatile("s_waitcnt vmcnt(0)" ::: "memory"); if (tstat && tid == 0) { tstat[0] += clock64() - te0_; } }
#else
        if constexpr (FP8) { int l_; asm volatile("v_mbcnt_lo_u32_b32 %0, -1, 0\n\tv_mbcnt_hi_u32_b32 %0, -1, %0" : "=v"(l_)); E(acc, cur, wr, wc, l_ & 15, l_ >> 4); }
        else E(acc, cur, wr, wc, fr, fq);
#endif
        if (!has_next) break;
        if (!E.keep(cur))
#pragma unroll
        for (int a = 0; a < 2; ++a)
#pragma unroll
            for (int b = 0; b < 2; ++b)
#pragma unroll
                for (int m = 0; m < 4; ++m)
#pragma unroll
                    for (int n = 0; n < 2; ++n) acc[a][b][m][n] = (f32x4){0.f, 0.f, 0.f, 0.f};
        cur = nxt; cA = nA; cB = nB; ++ui;
        if constexpr (ALIGN_EPI) { if (wr == 1) PG8_BAR; }
    }
    PG8_WAIT_V(0);
    if constexpr (!ALIGN_EPI) { if (wr == 0) PG8_BAR; }
    PG8_BAR;
#ifdef PROBE_GEMM_TIME
    if (tstat && tid == 0) tstat[1] += clock64() - tph0_;
#endif
#undef PG8_SA
#undef PG8_PA
#undef PG8_PB
#undef PG8_SB
#undef PG8_STAGE
#undef PG8_LDA
#undef PG8_LDB
#undef PG8_MMA
#undef PG8_WAIT_V
#undef PG8_WAIT_L
#undef PG8_BAR
#undef PG8_SCHED
}
}


constexpr int BATCH = 2, SEQ = 8192, DM = 2048, MROWS = BATCH * SEQ;
constexpr int HD = 128, NHEAD = 8, WATT = NHEAD * HD;
constexpr int NIH = 16, IDIM = 64, TOPK = 256;
constexpr int FF = 5632, P_IN = 11344, N_IN_PAD = 11520;
constexpr float EPS = 1e-6f, LOG2E = 1.4426950408889634f;
constexpr float QK_SCALE = 0.08838834764831845f;
constexpr int NPH = 12;
constexpr int N_LAUNCHES = MK_N_LAUNCHES;
constexpr int NWAVES = 8;

constexpr size_t MiB = 1u << 20;
constexpr size_t WS_CTL = 0, WS_BM = 1 * MiB, ZERO_BYTES = 1 * MiB;
constexpr size_t WS_MOD = 17 * MiB;
constexpr size_t WS_WIN = 18 * MiB;
constexpr size_t WS_WOSB = 63 * MiB, WS_WODS = 67 * MiB, WS_WOUT = 71 * MiB;
constexpr size_t WS_WGU = 79 * MiB;
constexpr size_t WS_WDN = 123 * MiB;
constexpr size_t WS_H = 145 * MiB;
constexpr size_t WS_SEG = 209 * MiB, SEG_BYTES = 32 * MiB;
constexpr size_t WS_KIX = 433 * MiB, WS_WIX = 435 * MiB, WS_D1 = 436 * MiB, WS_END = 500 * MiB;
constexpr size_t WS_ACT = WS_SEG;
constexpr size_t HALO_BYTES = (size_t)512 * FF * 4;
constexpr size_t WS_GHALO = WS_WIN, WS_GDEF = WS_WIN + 12 * MiB, WS_UDEF = WS_WIN + 24 * MiB;
static_assert(WS_WIN + (size_t)N_IN_PAD * DM * 2 <= WS_WOSB && WS_WGU + (size_t)2 * FF * DM * 2 <= WS_WDN && WS_WDN + (size_t)DM * FF * 2 <= WS_H && WS_H + (size_t)MROWS * DM * 2 <= WS_SEG, "ws map");
static_assert(WS_SEG + 7 * SEG_BYTES <= WS_KIX && WS_ACT + (size_t)MROWS * FF * 2 <= WS_KIX && HALO_BYTES <= 12 * MiB && WS_UDEF + HALO_BYTES <= WS_WOSB, "ws map 2");
constexpr float WGU_QS = 127.0f * 45.254834f / 4.5f;
constexpr size_t WS_SA1 = WS_MOD + 256 * 1024;
constexpr size_t WS_SA = WS_MOD + 512 * 1024;
constexpr float H8_SCALE = 8.0f, W8_SCALE = 64.0f;
constexpr size_t WS_WG8 = WS_WIN + (size_t)7168 * DM * 2;
constexpr size_t OUT_H8 = (size_t)64 * MiB;
constexpr int CW_BAR = 4096;

constexpr int RING_OFF = 0, RING_BYTES = 131072;
constexpr int LDSCTL_OFF = RING_BYTES, MISC_OFF = LDSCTL_OFF + 320;
constexpr int EXTRA_OFF = 131584;
constexpr int LDS_BYTES = 147456;

#define GAS __attribute__((address_space(1)))
#define LAS __attribute__((address_space(3)))
typedef unsigned short bf16;
typedef float f32x4 __attribute__((ext_vector_type(4)));
typedef float f32x16 __attribute__((ext_vector_type(16)));
typedef short bf16x8 __attribute__((ext_vector_type(8)));
typedef short s16x4 __attribute__((ext_vector_type(4)));
typedef unsigned u32x4 __attribute__((ext_vector_type(4)));
typedef unsigned u32x2 __attribute__((ext_vector_type(2)));
typedef unsigned short u16x2 __attribute__((ext_vector_type(2)));
typedef unsigned long long u64;
typedef GAS unsigned gu32;
#define LDS_WAIT() asm volatile("s_waitcnt lgkmcnt(0)" ::: "memory")
#define VM_WAIT() asm volatile("s_waitcnt vmcnt(0)" ::: "memory")
#define SBAR() __builtin_amdgcn_sched_barrier(0)
#define XB_TMO      128
#define XB_XCNT(j)  (256  + 64 * (j))
#define XB_XSUB(j)  (1280 + 64 * (j))
#define XB_XGEN(j)  (2304 + 64 * (j))
#define XB_TOP      3328
#define XB_TOPGEN   3392
#define XCD_BAR_WORDS 3456
#define XB_SPIN_CAP (1u << 18)

__device__ __forceinline__ unsigned xb_ld(unsigned* p)              { return __hip_atomic_load(p, __ATOMIC_RELAXED, __HIP_MEMORY_SCOPE_AGENT); }
__device__ __forceinline__ unsigned xb_add(unsigned* p, unsigned v) { return __hip_atomic_fetch_add(p, v, __ATOMIC_RELAXED, __HIP_MEMORY_SCOPE_AGENT); }
__device__ __forceinline__ unsigned xb_xcc_id() { return (unsigned)__builtin_amdgcn_s_getreg((3 << 11) | 20) & 0xFu; }
#define XB_SPIN(cond, bar) do { unsigned _sp = 0; while (cond) { __builtin_amdgcn_s_sleep(1); \
    if ((++_sp & 255u) == 0u) { if (xb_ld(&(bar)[XB_TMO])) break; if (_sp > XB_SPIN_CAP) { atomicAdd(&(bar)[XB_TMO], 1u); break; } } } } while (0)

struct XcdBarrier {
    unsigned* bar; unsigned x;
    volatile LAS unsigned* st;
};

__device__ __forceinline__ XcdBarrier xcd_barrier_post(unsigned* bar, volatile LAS unsigned* st, const bool thread0  ) {
    XcdBarrier b; b.bar = bar; b.x = xb_xcc_id(); b.st = st;
    if (thread0) (void)xb_add(&bar[XB_XCNT(b.x)], 1u);
    return b;
}
__device__ __forceinline__ void xcd_barrier_complete(unsigned* bar, unsigned x, unsigned& nloc, unsigned& nx) {
    const unsigned G = gridDim.x * gridDim.y * gridDim.z;
    unsigned sum, cnt, mine, sp = 0u;
    for (;;) {
        sum = 0u; cnt = 0u; mine = 0u;
#pragma unroll
        for (unsigned j = 0; j < 16; ++j) { const unsigned c = xb_ld(&bar[XB_XCNT(j)]); sum += c; cnt += (c > 0u) ? 1u : 0u; mine = (j == x) ? c : mine; }
        if (sum == G) break;
        __builtin_amdgcn_s_sleep(1);
        if ((++sp & 255u) == 0u) { if (xb_ld(&bar[XB_TMO])) break; if (sp > XB_SPIN_CAP) { atomicAdd(&bar[XB_TMO], 1u); break; } }
    }
    nloc = mine > 0u ? mine : 1u; nx = cnt > 0u ? cnt : 1u;
}

__device__ __forceinline__ void xcd_barrier(const XcdBarrier& b, const bool thread0  ) {
    asm volatile("s_waitcnt vmcnt(0)" ::: "memory");
    __syncthreads();
    if (thread0) {
        unsigned* bar = b.bar;
        __builtin_amdgcn_s_waitcnt(0);
        unsigned nloc = b.st[0], nx = b.st[1];
        if (nloc == 0u) { xcd_barrier_complete(bar, b.x, nloc, nx); b.st[0] = nloc; b.st[1] = nx; }
        const unsigned old = xb_add(&bar[XB_XSUB(b.x)], 1u);
        const unsigned gen = old / nloc;
        if (old + 1u == (gen + 1u) * nloc) {
            __builtin_amdgcn_fence(__ATOMIC_RELEASE, "agent");
            asm volatile("s_waitcnt vmcnt(0)" ::: "memory");
            const unsigned og = xb_add(&bar[XB_TOP], 1u);
            const unsigned tg = og / nx;
            if (og + 1u == (tg + 1u) * nx) xb_add(&bar[XB_TOPGEN], 1u);
            else XB_SPIN(xb_ld(&bar[XB_TOPGEN]) == tg, bar);
            __builtin_amdgcn_fence(__ATOMIC_ACQUIRE, "agent");
            xb_add(&bar[XB_XGEN(b.x)], 1u);
            asm volatile("s_waitcnt vmcnt(0)" ::: "memory");
        } else {
            XB_SPIN(xb_ld(&bar[XB_XGEN(b.x)]) == gen, bar);
            __builtin_amdgcn_fence(__ATOMIC_ACQUIRE, "agent");
            asm volatile("s_waitcnt vmcnt(0)" ::: "memory");
        }
    }
    __syncthreads();
}

struct Frame {
    LAS unsigned char* lds;
    volatile LAS unsigned* MISC;
    int tid, lane, wave;
    int vcu, G;
};
__device__ __forceinline__ float wave_sum(float v) {
#pragma unroll
    for (int o = 1; o < 64; o <<= 1) v += __shfl_xor(v, o);
    return v;
}
__device__ __forceinline__ int wave_sum_i(int v) {
#pragma unroll
    for (int o = 1; o < 64; o <<= 1) v += __shfl_xor(v, o);
    return v;
}
__device__ __forceinline__ unsigned pk2(float lo, float hi) { return pg8::cvt_pk_bf16(lo, hi); }
__device__ __forceinline__ unsigned cvtpk(float lo, float hi) { return pg8::cvt_pk_bf16(lo, hi); }


__device__ __forceinline__ f32x16 MFMA32(bf16x8 a, bf16x8 b, f32x16 c) { return __builtin_amdgcn_mfma_f32_32x32x16_f16(__builtin_bit_cast(pg8::h16x8, a), __builtin_bit_cast(pg8::h16x8, b), c, 0, 0, 0); }
__device__ __forceinline__ void ph0_mod(const Frame& F, const float* c, const float* w_ada, const float* b_ada, float* mod) {
    LAS float* sc = (LAS float*)(F.lds);
    LAS float* part = (LAS float*)(F.lds + 16384);
    for (int i = F.tid; i < 2 * DM; i += NWAVES * 64) { const float v = c[i]; sc[i] = v / (1.f + __expf(-v)); }
    __syncthreads();
    for (int cg = F.vcu; cg < 256; cg += F.G) {
        const int c4 = F.tid % 12, dr = F.tid / 12;
        if (dr < 42) {
            f32x4 a0 = {0.f, 0.f, 0.f, 0.f}, a1 = {0.f, 0.f, 0.f, 0.f};
            const float* wp = w_ada + (size_t)48 * cg + 4 * c4;
#pragma unroll 8
            for (int d = dr; d < DM; d += 42) { const f32x4 w = *(const f32x4*)(wp + (size_t)d * (6 * DM)); a0 += sc[d] * w; a1 += sc[DM + d] * w; }
#pragma unroll
            for (int e = 0; e < 4; ++e) { part[dr * 96 + 4 * c4 + e] = a0[e]; part[dr * 96 + 48 + 4 * c4 + e] = a1[e]; }
        }
        __syncthreads();
        if (F.tid < 96) { float s = 0.f; for (int r = 0; r < 42; ++r) s += part[r * 96 + F.tid]; const int b = F.tid / 48, col = F.tid % 48; mod[b * (6 * DM) + 48 * cg + col] = s + b_ada[48 * cg + col]; }
        __syncthreads();
    }
}
template <int MODE> __device__ __forceinline__ int row_map(int n, int off) {
    if (MODE == 0 || MODE == 4) return off + n;
    if (MODE == 1) return n < 2048 ? n : (n < 7168 ? n - 4096   : (n < 7248 ? 11264 + (n - 7168) : 7168 + (n - 7248)));
    if (MODE == 2) return (n >> 7) * 256 + (n & 127);
    return (n >> 7) * 256 + 128 + (n & 127);
}
template <int MODE> __device__ __forceinline__ void tr_item(const float* W, int K, int N, bf16* WT, int off, LAS float* scr, int item, int lane) {
    const int nblk = (N + 31) / 32, kb = item / nblk, nb = item % nblk, k0 = 64 * kb, n0 = 32 * nb;
    const bool cok = (n0 + (lane & 31)) < N;
    float tv[32];
#pragma unroll
    for (int i = 0; i < 32; ++i) { const int kk = 2 * i + (lane >> 5); tv[i] = cok ? W[(size_t)(k0 + kk) * N + n0 + (lane & 31)] : 0.f; }
#pragma unroll
    for (int i = 0; i < 32; ++i) { const int kk = 2 * i + (lane >> 5); scr[kk * 33 + (lane & 31)] = tv[i]; }
    LDS_WAIT(); asm volatile("" ::: "memory");
    const int c = lane & 7;
#pragma unroll
    for (int j = 0; j < 4; ++j) { const int n = (lane >> 3) + 8 * j; const LAS float* s = scr + (8 * c) * 33 + n;
        u32x4 o; o.x = pk2(s[0 * 33], s[1 * 33]); o.y = pk2(s[2 * 33], s[3 * 33]); o.z = pk2(s[4 * 33], s[5 * 33]); o.w = pk2(s[6 * 33], s[7 * 33]);
        if (MODE == 1 && (n0 + n >= 7248 || (n0 + n >= 2048 && n0 + n < 6144))) {
            const int r8 = (n0 + n >= 7248) ? (n0 + n - 7248) : (4096 + n0 + n - 2048);
            if (n0 + n < N) { unsigned a = 0u, b = 0u;
#pragma unroll
                for (int e = 0; e < 4; ++e) { int qa = (int)rintf(s[e * 33] * WGU_QS), qb = (int)rintf(s[(4 + e) * 33] * WGU_QS); qa = qa < -127 ? -127 : (qa > 127 ? 127 : qa); qb = qb < -127 ? -127 : (qb > 127 ? 127 : qb);
                    a |= ((unsigned)qa & 0xffu) << (8 * e); b |= ((unsigned)qb & 0xffu) << (8 * e); }
                u32x2 o8; o8.x = a; o8.y = b; *(GAS u32x2*)((unsigned char*)WT + (size_t)7168 * K * 2 + (size_t)r8 * K + k0 + 8 * c) = o8; } }
        else if (MODE == 2 || MODE == 3 || MODE == 4) {
            if (n0 + n < N) { unsigned lo = 0u, hi = 0u;
#pragma unroll
                for (int e = 0; e < 4; ++e) { int qa = (int)rintf(s[e * 33] * WGU_QS), qb = (int)rintf(s[(4 + e) * 33] * WGU_QS); qa = qa < -127 ? -127 : (qa > 127 ? 127 : qa); qb = qb < -127 ? -127 : (qb > 127 ? 127 : qb);
                    lo |= ((unsigned)qa & 0xffu) << (8 * e); hi |= ((unsigned)qb & 0xffu) << (8 * e); }
                u32x2 o8; o8.x = lo; o8.y = hi; *(GAS u32x2*)((unsigned char*)WT + (size_t)row_map<MODE>(n0 + n, off) * K + k0 + 8 * c) = o8; } }
        else if (n0 + n < N) *(GAS u32x4*)(WT + (size_t)row_map<MODE>(n0 + n, off) * K + k0 + 8 * c) = o; }
    LDS_WAIT(); asm volatile("" ::: "memory");
}
struct WPtrs { const float *w_in, *w_osb, *w_ods, *w_out, *w_gate, *w_up, *w_down; bf16 *t_in, *t_osb, *t_ods, *t_out, *t_gu, *t_dn; };
__device__ __forceinline__ void ph0_weights(const Frame& F, const WPtrs& P, int part, int wg, int nwg) {
    LAS float* scr = (LAS float*)(F.lds + RING_OFF + F.wave * 16384);
    const int gw = wg * NWAVES + F.wave, NGW = nwg * NWAVES;
    constexpr int I_IN = (DM / 64) * ((P_IN + 31) / 32), I_O = (WATT / 64) * (DM / 32), I_OUT = (DM / 64) * (DM / 32), I_G = (DM / 64) * (FF / 32), I_D = (FF / 64) * (DM / 32);
    if (part == 0) {
        for (int it = gw; it < I_IN; it += NGW) tr_item<1>(P.w_in, DM, P_IN, P.t_in, 0, scr, it, F.lane);
        GAS u32x4* z = (GAS u32x4*)(P.t_in + (size_t)P_IN * DM); const int n16 = (N_IN_PAD - P_IN) * DM * 2 / 16;
        for (int i = wg * (NWAVES * 64) + F.tid; i < n16; i += nwg * NWAVES * 64) z[i] = (u32x4){0u, 0u, 0u, 0u};
    } else {
        constexpr int NITEMS = 2 * I_O + I_OUT + 2 * I_G + I_D;
        for (int it = gw; it < NITEMS; it += NGW) {
            int r = it;
            if (r < I_O) { tr_item<0>(P.w_osb, WATT, DM, P.t_osb, 0, scr, r, F.lane); continue; } r -= I_O;
            if (r < I_O) { tr_item<0>(P.w_ods, WATT, DM, P.t_ods, 0, scr, r, F.lane); continue; } r -= I_O;
            if (r < I_OUT) { tr_item<4>(P.w_out, DM, DM, P.t_out, 0, scr, r, F.lane); continue; } r -= I_OUT;
            if (r < I_G) { tr_item<2>(P.w_gate, DM, FF, P.t_gu, 0, scr, r, F.lane); continue; } r -= I_G;
            if (r < I_G) { tr_item<3>(P.w_up, DM, FF, P.t_gu, 0, scr, r, F.lane); continue; } r -= I_G;
            tr_item<0>(P.w_down, FF, DM, P.t_dn, 0, scr, r, F.lane);
        }
    }
}

template <int MODE> __device__ __forceinline__ void norm_mod_rows(const Frame& F, const void* X, bf16* C, bf16* H, unsigned char* Q8, float* SA, const float* g, const float* shift, const float* scale) {
    const int gw = F.vcu * NWAVES + F.wave, NGW = F.G * NWAVES;
    for (int rb = gw; rb < MROWS / 8; rb += NGW) {
        const int b = (rb * 8) / SEQ;
        f32x4 gs[8], sh[8];
#pragma unroll
        for (int j = 0; j < 8; ++j) { const int col = 4 * (64 * j + F.lane); gs[j] = *(const f32x4*)(g + col) * (1.0f + *(const f32x4*)(scale + (size_t)b * 6 * DM + col)); sh[j] = *(const f32x4*)(shift + (size_t)b * 6 * DM + col); }
        for (int rr = 0; rr < 8; ++rr) {
            const size_t row = (size_t)rb * 8 + rr;
            f32x4 v[8]; float s = 0.f;
            if (MODE == 0) { const GAS f32x4* xr = (const GAS f32x4*)((const float*)X + row * DM) + F.lane;
#pragma unroll
                for (int j = 0; j < 8; ++j) v[j] = xr[64 * j];
                GAS u32x2* xo = (GAS u32x2*)(C + row * DM) + F.lane;
#pragma unroll
                for (int j = 0; j < 8; ++j) { u32x2 w; w.x = cvtpk(v[j].x, v[j].y); w.y = cvtpk(v[j].z, v[j].w); xo[64 * j] = w; } }
            else { const GAS u32x2* dr = (const GAS u32x2*)((const bf16*)X + row * DM) + F.lane; u32x2 hv[8];
#pragma unroll
                for (int j = 0; j < 8; ++j) hv[j] = dr[64 * j];
#pragma unroll
                for (int j = 0; j < 8; ++j) v[j] = (f32x4){pg8::bf_lo(hv[j].x), pg8::bf_hi(hv[j].x), pg8::bf_lo(hv[j].y), pg8::bf_hi(hv[j].y)}; }
#pragma unroll
            for (int j = 0; j < 8; ++j) s += (v[j].x * v[j].x + v[j].y * v[j].y) + (v[j].z * v[j].z + v[j].w * v[j].w);
            const float rs = 1.0f / sqrtf(wave_sum(s) * (1.0f / DM) + EPS);
            f32x4 y[8]; float mx = 0.f;
#pragma unroll
            for (int j = 0; j < 8; ++j) { y[j] = v[j] * rs * gs[j] + sh[j]; mx = fmaxf(mx, fmaxf(fmaxf(fabsf(y[j].x), fabsf(y[j].y)), fmaxf(fabsf(y[j].z), fabsf(y[j].w)))); }
            if (MODE == 0) { GAS u32x2* o8 = (GAS u32x2*)(H + row * DM) + F.lane;
#pragma unroll
                for (int j = 0; j < 8; ++j) { u32x2 w; w.x = cvtpk(y[j].x, y[j].y); w.y = cvtpk(y[j].z, y[j].w); o8[64 * j] = w; } }
#pragma unroll
            for (int o = 1; o < 64; o <<= 1) mx = fmaxf(mx, __shfl_xor(mx, o));
            mx = fmaxf(mx, 1e-20f);
            const float inv = 127.0f / mx;
            GAS unsigned* oq = (GAS unsigned*)((MODE == 0 ? Q8 : (unsigned char*)H) + row * DM) + F.lane;
#pragma unroll
            for (int j = 0; j < 8; ++j) { const int q0 = (int)rintf(y[j].x * inv), q1 = (int)rintf(y[j].y * inv), q2 = (int)rintf(y[j].z * inv), q3 = (int)rintf(y[j].w * inv);
                oq[64 * j] = ((unsigned)q0 & 0xffu) | (((unsigned)q1 & 0xffu) << 8) | (((unsigned)q2 & 0xffu) << 16) | ((unsigned)q3 << 24); }
            if (F.lane == 0) SA[row] = mx * (1.0f / (127.0f * WGU_QS));
        }
    }
}
__device__ __forceinline__ void norm_final_rows(const Frame& F, const bf16* X1, const bf16* D2, float* O, const float* g) {
    const int gw = F.vcu * NWAVES + F.wave, NGW = F.G * NWAVES;
    f32x4 gs[8];
#pragma unroll
    for (int j = 0; j < 8; ++j) gs[j] = *(const f32x4*)(g + 4 * (64 * j + F.lane));
    for (int row = gw; row < MROWS; row += NGW) {
        GAS f32x4* orow = (GAS f32x4*)(O + (size_t)row * DM) + F.lane;
        const GAS u32x2* d1 = (const GAS u32x2*)(X1 + (size_t)row * DM) + F.lane; const GAS u32x2* d2 = (const GAS u32x2*)(D2 + (size_t)row * DM) + F.lane;
        f32x4 v[8]; u32x2 h1[8], h2[8]; float s = 0.f;
#pragma unroll
        for (int j = 0; j < 8; ++j) { h1[j] = d1[64 * j]; h2[j] = d2[64 * j]; }
#pragma unroll
        for (int j = 0; j < 8; ++j) { v[j] = (f32x4){pg8::bf_lo(h1[j].x), pg8::bf_hi(h1[j].x), pg8::bf_lo(h1[j].y), pg8::bf_hi(h1[j].y)} + (f32x4){pg8::bf_lo(h2[j].x), pg8::bf_hi(h2[j].x), pg8::bf_lo(h2[j].y), pg8::bf_hi(h2[j].y)};
            s += (v[j].x * v[j].x + v[j].y * v[j].y) + (v[j].z * v[j].z + v[j].w * v[j].w); }
        const float rs = 1.0f / sqrtf(wave_sum(s) * (1.0f / DM) + EPS);
#pragma unroll
        for (int j = 0; j < 8; ++j) orow[64 * j] = v[j] * rs * gs[j];
    }
}

namespace att {
constexpr int PITCH = WATT;
constexpr int SHM_T = 16384;
constexpr int OFF_V = 0, OFF_K = 3 * SHM_T, OFF_WS = 5 * SHM_T, OFF_TAB = OFF_WS + 2048, OFF_FLAG = OFF_TAB + 512;
#define KSWZ(row, colB) ((row) * 256 + ((colB) ^ (((row) & 7) << 4)))
__device__ __forceinline__ int v_st(int k, int c) { const int kk = (k & ~0xC) | ((k & 4) << 1) | ((k & 8) >> 1); return ((kk >> 3) * 4 + (c >> 5)) * 512 + ((kk & 7) * 32 + (c & 31)) * 2; }
__device__ __forceinline__ int v_rd_base(int lane) { return ((lane & 3) << 3) | (((lane >> 2) & 3) << 6) | (((lane >> 4) & 1) << 5) | (((lane >> 5) & 1) << 8); }
constexpr int v_rd_off(int d0, int ks, int half) { return d0 * 512 + ks * 4096 + half * 2048; }
__device__ __forceinline__ int crow(int r, int hi) { return (r & 3) + 8 * (r >> 2) + 4 * hi; }

__device__ __forceinline__ void qkt(f32x16& p0, f32x16& p1, const LAS char* Kb, int r32, int hi, const bf16x8* qr) {
    p0 = f32x16{}; p1 = f32x16{};
    const LAS char* kb[4];
#pragma unroll
    for (int dd = 0; dd < 4; ++dd) kb[dd] = Kb + KSWZ(r32, (dd * 16 + hi * 8) * 2);
#pragma unroll
    for (int d0 = 0; d0 < 8; ++d0) { const LAS char* a = kb[d0 & 3] + (d0 >> 2) * 128;
        const bf16x8 b0 = *(const LAS bf16x8*)a;
        const bf16x8 b1 = *(const LAS bf16x8*)(a + 32 * 256);
        p0 = MFMA32(b0, qr[d0], p0);
        p1 = MFMA32(b1, qr[d0], p1); }
}
__device__ __forceinline__ void pv_tile(f32x16* o, int vb0, bf16x8 pa0, bf16x8 pa1, bf16x8 pa2, bf16x8 pa3) {
#define TRRD(dst, off) asm volatile("ds_read_b64_tr_b16 %0, %1 offset:%2" : "=&v"(dst) : "v"(vb0), "i"(off) : "memory")
#define PV_D0(d0) do { s16x4 l0, l1, l2, l3, h0, h1, h2, h3; constexpr int b_ = v_rd_off(d0, 0, 0); \
        TRRD(l0, b_); TRRD(h0, b_ + 2048); TRRD(l1, b_ + 4096); TRRD(h1, b_ + 6144); TRRD(l2, b_ + 8192); TRRD(h2, b_ + 10240); TRRD(l3, b_ + 12288); TRRD(h3, b_ + 14336); \
        asm volatile("s_waitcnt lgkmcnt(0)" ::: "memory"); SBAR(); \
        o[d0] = MFMA32(pa0, (bf16x8){l0[0], l0[1], l0[2], l0[3], h0[0], h0[1], h0[2], h0[3]}, o[d0]);   \
        o[d0] = MFMA32(pa1, (bf16x8){l1[0], l1[1], l1[2], l1[3], h1[0], h1[1], h1[2], h1[3]}, o[d0]);   \
        o[d0] = MFMA32(pa2, (bf16x8){l2[0], l2[1], l2[2], l2[3], h2[0], h2[1], h2[2], h2[3]}, o[d0]);   \
        o[d0] = MFMA32(pa3, (bf16x8){l3[0], l3[1], l3[2], l3[3], h3[0], h3[1], h3[2], h3[3]}, o[d0]); } while (0)
    PV_D0(0); PV_D0(1); PV_D0(2); PV_D0(3);
#undef PV_D0
#undef TRRD
}
template <int HALF> __device__ __forceinline__ void qkt_half(f32x16& p, const LAS char* Kb, int r32, int hi, const bf16x8* qr) {
    p = f32x16{};
    const LAS char* kb[4];
#pragma unroll
    for (int dd = 0; dd < 4; ++dd) kb[dd] = Kb + KSWZ(r32, (dd * 16 + hi * 8) * 2);
#pragma unroll
    for (int d0 = 0; d0 < 8; ++d0) { const LAS char* a = kb[d0 & 3] + (d0 >> 2) * 128 + HALF * 32 * 256;
        p = MFMA32(*(const LAS bf16x8*)a, qr[d0], p); }
}
template <int HALF> __device__ __forceinline__ void pv_half(f32x16* o, int vb0, bf16x8 pa0, bf16x8 pa1) {
#define TRRD(dst, off) asm volatile("ds_read_b64_tr_b16 %0, %1 offset:%2" : "=&v"(dst) : "v"(vb0), "i"(off) : "memory")
#define PV_D0(d0) do { s16x4 l0, l1, h0, h1; constexpr int b_ = v_rd_off(d0, 2 * HALF, 0); \
        TRRD(l0, b_); TRRD(h0, b_ + 2048); TRRD(l1, b_ + 4096); TRRD(h1, b_ + 6144); \
        asm volatile("s_waitcnt lgkmcnt(0)" ::: "memory"); SBAR(); \
        o[d0] = MFMA32(pa0, (bf16x8){l0[0], l0[1], l0[2], l0[3], h0[0], h0[1], h0[2], h0[3]}, o[d0]);   \
        o[d0] = MFMA32(pa1, (bf16x8){l1[0], l1[1], l1[2], l1[3], h1[0], h1[1], h1[2], h1[3]}, o[d0]); } while (0)
    PV_D0(0); PV_D0(1); PV_D0(2); PV_D0(3);
#undef PV_D0
#undef TRRD
}
typedef short v4i16_t __attribute__((ext_vector_type(4)));
__device__ __forceinline__ s16x4 vtr(const LAS char* p) { return __builtin_bit_cast(s16x4, __builtin_amdgcn_ds_read_tr16_b64_v4i16((LAS v4i16_t*)p)); }
template <int HALF> __device__ __forceinline__ void pv_half_b(f32x16* o, const LAS char* vbp, bf16x8 pa0, bf16x8 pa1) {
#pragma unroll
    for (int d0 = 0; d0 < 4; ++d0) { const LAS char* b_ = vbp + v_rd_off(d0, 2 * HALF, 0);
        const s16x4 l0 = vtr(b_), h0 = vtr(b_ + 2048), l1 = vtr(b_ + 4096), h1 = vtr(b_ + 6144);
        o[d0] = MFMA32(pa0, (bf16x8){l0[0], l0[1], l0[2], l0[3], h0[0], h0[1], h0[2], h0[3]}, o[d0]);
        o[d0] = MFMA32(pa1, (bf16x8){l1[0], l1[1], l1[2], l1[3], h1[0], h1[1], h1[2], h1[3]}, o[d0]); }
}
__device__ __forceinline__ float dot2_ones(unsigned w, float acc) { return __builtin_amdgcn_fdot2(__builtin_bit_cast(pg8::h16x2, w), (pg8::h16x2){(_Float16)1.0f, (_Float16)1.0f}, acc, false); }
__device__ __forceinline__ float pack_half(const f32x16& p, bf16x8& pa0, bf16x8& pa1) {
    float ps = 0.f;
#define PK4(P, B_, OUT) do { unsigned a0 = cvtpk(P[B_+0], P[B_+1]), a1 = cvtpk(P[B_+2], P[B_+3]);                          \
        unsigned b0 = cvtpk(P[B_+4], P[B_+5]), b1 = cvtpk(P[B_+6], P[B_+7]);                                             \
        ps = dot2_ones(a0, ps); ps = dot2_ones(a1, ps); ps = dot2_ones(b0, ps); ps = dot2_ones(b1, ps);                     \
        auto r0 = __builtin_amdgcn_permlane32_swap(a0, b0, false, false); auto r1 = __builtin_amdgcn_permlane32_swap(a1, b1, false, false); \
        u32x4 w = {r0[0], r1[0], r0[1], r1[1]}; OUT = *reinterpret_cast<bf16x8*>(&w); } while (0)
    PK4(p, 0, pa0); PK4(p, 8, pa1);
#undef PK4
    return ps;
}
__device__ __forceinline__ void pack_p(const f32x16& p0, const f32x16& p1, bf16x8& pa0, bf16x8& pa1, bf16x8& pa2, bf16x8& pa3) {
#define PK4(P, B_, OUT) do { unsigned a0 = cvtpk(P[B_+0], P[B_+1]), a1 = cvtpk(P[B_+2], P[B_+3]);                          \
        unsigned b0 = cvtpk(P[B_+4], P[B_+5]), b1 = cvtpk(P[B_+6], P[B_+7]);                                             \
        auto r0 = __builtin_amdgcn_permlane32_swap(a0, b0, false, false); auto r1 = __builtin_amdgcn_permlane32_swap(a1, b1, false, false); \
        u32x4 w = {r0[0], r1[0], r0[1], r1[1]}; OUT = *reinterpret_cast<bf16x8*>(&w); } while (0)
    PK4(p0, 0, pa0); PK4(p0, 8, pa1); PK4(p1, 0, pa2); PK4(p1, 8, pa3);
#undef PK4
}
__device__ __forceinline__ float swap_other(float own, int hi) {
    auto rr = __builtin_amdgcn_permlane32_swap(__float_as_uint(own), __float_as_uint(own), false, false);
    return hi ? __uint_as_float(rr[0]) : __uint_as_float(rr[1]);
}
struct Stage { bf16x8 k0, k1, v0, v1; };
__device__ __forceinline__ void stage_load(Stage& S, const bf16* Kp, const bf16* Vp, int key0, int sr, int sc) {
    const bf16* kp = Kp + (size_t)(key0 + sr) * PITCH + sc; const bf16* vp = Vp + (size_t)(key0 + sr) * PITCH + sc;
    S.k0 = *(const bf16x8*)kp; S.k1 = *(const bf16x8*)(kp + 32 * PITCH); S.v0 = *(const bf16x8*)vp; S.v1 = *(const bf16x8*)(vp + 32 * PITCH);
}
__device__ __forceinline__ void stage_write(const Stage& S, LAS char* Kl, LAS char* Vl, int kws, int vst0, int vst1) {
    *(LAS bf16x8*)(Kl + kws) = S.k0; *(LAS bf16x8*)(Kl + kws + 32 * 256) = S.k1; *(LAS bf16x8*)(Vl + vst0) = S.v0; *(LAS bf16x8*)(Vl + vst1) = S.v1;
}
__device__ __forceinline__ void store_o(const f32x16* o, const float* rscale  , bf16* Ow, int r32, int hi) {
    int lo = 4 * hi * PITCH + r32; asm volatile("" : "+v"(lo));
#pragma unroll
    for (int r = 0; r < 16; ++r) { const int orow = (r & 3) + 8 * (r >> 2);
#pragma unroll
        for (int d0 = 0; d0 < 4; ++d0) { const float v = rscale ? o[d0][r] * rscale[r] : o[d0][r]; const float vn = __shfl_xor(v, 1);
            if ((r32 & 1) == 0) *(unsigned*)(Ow + (size_t)(lo + orow * PITCH + d0 * 32)) = cvtpk(v, vn); } }
}

__device__ __forceinline__ void sb_math(f32x16& p0, f32x16& p1, float& R, int dq, bool need_mask, int hi) {
    constexpr float C2 = QK_SCALE * LOG2E;
    f32x16 k0, k1;
#pragma unroll
    for (int r = 0; r < 16; ++r) {
        const int c = (r & 3) + 8 * (r >> 2);
        { const float x = p0[r] * C2, t = __builtin_amdgcn_exp2f(-fabsf(x)), rr = __builtin_amdgcn_rcpf(1.0f + t), tr = t * rr; const bool pos = x >= 0.f;
          float be = pos ? rr : tr, ke = pos ? tr : rr; if (need_mask && !(c < dq)) { be = 0.f; ke = 1.f; } p0[r] = be; k0[r] = ke; }
        { const float x = p1[r] * C2, t = __builtin_amdgcn_exp2f(-fabsf(x)), rr = __builtin_amdgcn_rcpf(1.0f + t), tr = t * rr; const bool pos = x >= 0.f;
          float be = pos ? rr : tr, ke = pos ? tr : rr; if (need_mask && !(c + 32 < dq)) { be = 0.f; ke = 1.f; } p1[r] = be; k1[r] = ke; }
    }
    float L[9]; L[0] = 1.0f;
#pragma unroll
    for (int j = 0; j < 8; ++j) { const int g = 3 - (j & 3); const f32x16& kk = (j < 4) ? k1 : k0; L[j + 1] = L[j] * ((kk[4 * g] * kk[4 * g + 1]) * (kk[4 * g + 2] * kk[4 * g + 3])); }
#pragma unroll
    for (int j = 0; j < 8; ++j) {
        auto rr = __builtin_amdgcn_permlane32_swap(__float_as_uint(L[j + 1]), __float_as_uint(L[j]), false, false);
        const float foreign = hi ? __uint_as_float(rr[0]) : __uint_as_float(rr[1]);
        float P = R * (L[j] * foreign);
        const int g = 3 - (j & 3);
        if (j < 4) { p1[4 * g + 3] *= P; P *= k1[4 * g + 3]; p1[4 * g + 2] *= P; P *= k1[4 * g + 2]; p1[4 * g + 1] *= P; P *= k1[4 * g + 1]; p1[4 * g] *= P; }
        else       { p0[4 * g + 3] *= P; P *= k0[4 * g + 3]; p0[4 * g + 2] *= P; P *= k0[4 * g + 2]; p0[4 * g + 1] *= P; P *= k0[4 * g + 1]; p0[4 * g] *= P; }
    }
    R = R * (L[8] * swap_other(L[8], hi));
}
__device__ __forceinline__ void sb_block(const Frame& F, int b, int h, int qb, const bf16* Qb, const bf16* Kb, const bf16* Vb, bf16* Ob) {
    LAS char* lds = (LAS char*)F.lds;
    const int tid = F.tid, wid = F.wave, lane = F.lane, r32 = lane & 31, hi = lane >> 5;
    const int t0 = qb * 256, tq = t0 + wid * 32 + r32;
    const size_t rowbase = (size_t)b * SEQ;
    const bf16* Qp = Qb + (rowbase + t0) * PITCH + h * HD; bf16* Op = Ob + (rowbase + t0) * PITCH + h * HD;
    const bf16* Kp = Kb + rowbase * PITCH + h * HD; const bf16* Vp = Vb + rowbase * PITCH + h * HD;
    bf16x8 qr[8];
#pragma unroll
    for (int d0 = 0; d0 < 8; ++d0) qr[d0] = *(const bf16x8*)(Qp + (size_t)(wid * 32 + r32) * PITCH + d0 * 16 + hi * 8);
    const int sr = tid >> 4, sc = (tid & 15) * 8, kws = KSWZ(sr, sc * 2), vst0 = v_st(sr, sc), vst1 = vst0 + 8192  ;
    LAS char* Vl = lds + OFF_V; LAS char* Kl = lds + OFF_K;
    LAS unsigned* flags = (LAS unsigned*)(lds + OFF_FLAG);
    const int vb = (int)(size_t)Vl + v_rd_base(lane);
    float R = 1.0f; f32x16 o[4] = {};
    const int jmax = (t0 + 254) >> 6;
    const int jw = (t0 + wid * 32 + 30) >> 6;
    bool wdone = false;
    if (tid < 8) flags[tid] = 0u;
    Stage S; stage_load(S, Kp, Vp, jmax * 64, sr, sc); stage_write(S, Kl, Vl, kws, vst0, vst1);
    __syncthreads();
    int buf = 0;
    for (int j = jmax; j >= 0; --j) {
        if (j > 0) stage_load(S, Kp, Vp, (j - 1) * 64, sr, sc);
        if (!wdone && j <= jw) {
            f32x16 p0, p1; qkt(p0, p1, Kl + buf * SHM_T, r32, hi, qr);
            sb_math(p0, p1, R, tq - 64 * j - 4 * hi, 64 * j + 63 >= t0 + wid * 32, hi);
            bf16x8 pa0, pa1, pa2, pa3; pack_p(p0, p1, pa0, pa1, pa2, pa3);
            pv_tile(o, vb + buf * SHM_T, pa0, pa1, pa2, pa3);
#ifndef PROBE_NO_EXIT
            if (__all(R < 1e-30f)) { wdone = true; if (lane == 0) flags[wid] = 1u; }
#endif
        }
        if (j > 0) stage_write(S, Kl + (buf ^ 1) * SHM_T, Vl + (buf ^ 1) * SHM_T, kws, vst0, vst1);
        __syncthreads();
        buf ^= 1;
        if (j > 0) { const u32x4 f0 = *(const LAS u32x4*)flags, f1 = *(const LAS u32x4*)(flags + 4);
            if ((f0.x & f0.y & f0.z & f0.w & f1.x & f1.y & f1.z & f1.w) != 0u) break; }
    }
#ifdef PROBE_ZERO_SB
#pragma unroll
    for (int d = 0; d < 4; ++d) o[d] = f32x16{};
#endif
    store_o(o, nullptr, Op + (size_t)(wid * 32) * PITCH, r32, hi);
    __syncthreads();
}

__device__ __forceinline__ int t5_bucket(int n) {
    if (n < 16) return n;
    const int th[15] = {19, 21, 24, 27, 31, 35, 40, 46, 52, 59, 67, 77, 87, 99, 113};
    int bkt = 16;
#pragma unroll
    for (int i = 0; i < 15; ++i) bkt += (n >= th[i]) ? 1 : 0;
    return bkt;
}
__device__ __forceinline__ void dsa_block(const Frame& F, int b, int h, int qb, const bf16* Qb, const bf16* Kb, const bf16* Vb, bf16* Ob, const u64* BM, const float* relbias) {
    LAS char* lds = (LAS char*)F.lds;
    const int tid = F.tid, wid = F.wave, lane = F.lane, r32 = lane & 31, hi = lane >> 5;
    const int t0 = qb * 256, tq = t0 + wid * 32 + r32;
    const size_t rowbase = (size_t)b * SEQ;
    const bf16* Qp = Qb + (rowbase + t0) * PITCH + h * HD; bf16* Op = Ob + (rowbase + t0) * PITCH + h * HD;
    const bf16* Kp = Kb + rowbase * PITCH + h * HD; const bf16* Vp = Vb + rowbase * PITCH + h * HD;
    const u64* bmrow = BM + (rowbase + tq) * 128;
    bf16x8 qr[8];
#pragma unroll
    for (int d0 = 0; d0 < 8; ++d0) qr[d0] = *(const bf16x8*)(Qp + (size_t)(wid * 32 + r32) * PITCH + d0 * 16 + hi * 8);
    const int sr = tid >> 4, sc = (tid & 15) * 8, kws = KSWZ(sr, sc * 2), vst0 = v_st(sr, sc), vst1 = vst0 + 8192  ;
    LAS char* Vl = lds + OFF_V; LAS char* Kl = lds + OFF_K;
    LAS float* ws = (LAS float*)(lds + OFF_WS) + wid * 64; LAS float* li_l = ws; LAS float* al_l = ws + 32;
    LAS float* btab = (LAS float*)(lds + OFF_TAB);
    if (tid < 128) btab[tid] = relbias[t5_bucket(tid) * NHEAD + h] * LOG2E;
    const float bfar = relbias[31 * NHEAD + h] * LOG2E;
    const int vb = (int)(size_t)Vl + v_rd_base(lane);
    float m_reg = -1e30f, l_reg = 0.f; f32x16 o[4] = {};
    const int jmax = (t0 + 255) >> 6;
    const int jw = (t0 + wid * 32 + 31) >> 6;
    constexpr float C2 = QK_SCALE * LOG2E, THR2 = 8.0f * LOG2E, NEG = -__builtin_inff();
    Stage S; stage_load(S, Kp, Vp, 0, sr, sc); stage_write(S, Kl, Vl, kws, vst0, vst1);
    __syncthreads();
    int buf = 0;
#define DSA_RESC(alpha) do { if (__any(alpha < 1.0f)) { if (hi == 0) al_l[r32] = alpha; LDS_WAIT(); \
                _Pragma("unroll") for (int r = 0; r < 16; ++r) { const float a = al_l[crow(r, hi)]; \
                    _Pragma("unroll") for (int d = 0; d < 4; ++d) o[d][r] *= a; } \
                LDS_WAIT(); } } while (0)
#define DSA_SMF(HALF, p, pa0, pa1, alpha) do { \
            const unsigned mk = (unsigned)(mw >> (32 * HALF)) >> (4 * hi); \
            _Pragma("unroll") for (int r = 0; r < 16; ++r) { const int c = (r & 3) + 8 * (r >> 2); const unsigned m = (unsigned)__builtin_amdgcn_sbfe((int)mk, c, 1); \
                p[r] = __uint_as_float((__float_as_uint(p[r]) & m) | (0xff800000u & ~m)); } \
            float pmax = p[0]; _Pragma("unroll") for (int r = 1; r < 16; ++r) pmax = fmaxf(pmax, p[r]); \
            pmax = fmaf(pmax, C2, bfar); pmax = fmaxf(pmax, swap_other(pmax, hi)); \
            const bool keep = __all(pmax - m_reg <= THR2); \
            const float mn = keep ? m_reg : fmaxf(m_reg, pmax); \
            alpha = __builtin_amdgcn_exp2f(m_reg - mn); m_reg = mn; \
            const float kk = bfar - mn; \
            _Pragma("unroll") for (int r = 0; r < 16; ++r) p[r] = __builtin_amdgcn_exp2f(fmaf(p[r], C2, kk)); \
            float ps = pack_half(p, pa0, pa1); ps += swap_other(ps, hi); l_reg = l_reg * alpha + ps; } while (0)
#define DSA_SMN(HALF, p, pa0, pa1, alpha) do { \
            const unsigned mk = (unsigned)(mw >> (32 * HALF)) >> (4 * hi); \
            const int dq = tq - 64 * j - 32 * HALF - 4 * hi;             \
            _Pragma("unroll") for (int r = 0; r < 16; ++r) { const int c = (r & 3) + 8 * (r >> 2); int n0 = dq - c; n0 = n0 < 0 ? 0 : (n0 > 127 ? 127 : n0); \
                const float x0 = p[r] * C2 + btab[n0]; p[r] = ((mk >> c) & 1u) ? x0 : NEG; } \
            float pmax = p[0]; _Pragma("unroll") for (int r = 1; r < 16; ++r) pmax = fmaxf(pmax, p[r]); \
            pmax = fmaxf(pmax, swap_other(pmax, hi)); \
            const bool keep = __all(pmax - m_reg <= THR2); \
            const float mn = keep ? m_reg : fmaxf(m_reg, pmax); \
            alpha = __builtin_amdgcn_exp2f(m_reg - mn); m_reg = mn; \
            _Pragma("unroll") for (int r = 0; r < 16; ++r) p[r] = __builtin_amdgcn_exp2f(p[r] - mn); \
            float ps = pack_half(p, pa0, pa1); ps += swap_other(ps, hi); l_reg = l_reg * alpha + ps; } while (0)
#define SGB_MFMA_VALU(nm, nv) do { _Pragma("unroll") for (int g_ = 0; g_ < (nm); ++g_) { __builtin_amdgcn_sched_group_barrier(0x008, 1, 0); __builtin_amdgcn_sched_group_barrier(0x002, (nv), 0); } } while (0)
#define DSA_SMF2(p0, p1, pa0, pa1, pa2, pa3, alpha) do { \
            const unsigned mk0 = (unsigned)mw >> (4 * hi), mk1 = (unsigned)(mw >> 32) >> (4 * hi); \
            _Pragma("unroll") for (int r = 0; r < 16; ++r) { const int c = (r & 3) + 8 * (r >> 2); \
                const unsigned m0 = (unsigned)__builtin_amdgcn_sbfe((int)mk0, c, 1), m1 = (unsigned)__builtin_amdgcn_sbfe((int)mk1, c, 1); \
                p0[r] = __uint_as_float((__float_as_uint(p0[r]) & m0) | (0xff800000u & ~m0)); p1[r] = __uint_as_float((__float_as_uint(p1[r]) & m1) | (0xff800000u & ~m1)); } \
            float pmax = fmaxf(p0[0], p1[0]); _Pragma("unroll") for (int r = 1; r < 16; ++r) pmax = fmaxf(pmax, fmaxf(p0[r], p1[r])); \
            pmax = fmaf(pmax, C2, bfar); pmax = fmaxf(pmax, swap_other(pmax, hi)); \
            const bool keep = __all(pmax - m_reg <= THR2); \
            const float mn = keep ? m_reg : fmaxf(m_reg, pmax); \
            alpha = __builtin_amdgcn_exp2f(m_reg - mn); m_reg = mn; \
            const float kk = bfar - mn; \
            _Pragma("unroll") for (int r = 0; r < 16; ++r) p0[r] = __builtin_amdgcn_exp2f(fmaf(p0[r], C2, kk)); \
            float ps = pack_half(p0, pa0, pa1); \
            _Pragma("unroll") for (int r = 0; r < 16; ++r) p1[r] = __builtin_amdgcn_exp2f(fmaf(p1[r], C2, kk)); \
            ps += pack_half(p1, pa2, pa3); ps += swap_other(ps, hi); l_reg = l_reg * alpha + ps; } while (0)
    int J1 = ((t0 - 176) >> 6) + 1; J1 = J1 < 0 ? 0 : (J1 > jmax + 1 ? jmax + 1 : J1);
    int j = 0, vi = 0;
    u64 mw_next = bmrow[0];
    if (wid < 4) {
        for (; j < J1; ++j) {
            const u64 mw = mw_next; if (j < jw) mw_next = bmrow[j + 1];
            if (j < jmax) stage_load(S, Kp, Vp, (j + 1) * 64, sr, sc);
            const int vn = vi == 2 ? 0 : vi + 1;
            {
                f32x16 pA, pB; bf16x8 a0, a1, b0, b1; float al0, al1;
                const LAS char* vbp = Vl + vi * SHM_T + v_rd_base(lane);
                SBAR(); qkt_half<0>(pA, Kl + buf * SHM_T, r32, hi, qr); SBAR();
                qkt_half<1>(pB, Kl + buf * SHM_T, r32, hi, qr);
                DSA_SMF(0, pA, a0, a1, al0);
                SGB_MFMA_VALU(8, 14);
                SBAR(); DSA_RESC(al0); SBAR();
                pv_half_b<0>(o, vbp, a0, a1);
                DSA_SMF(1, pB, b0, b1, al1);
                SGB_MFMA_VALU(8, 14);
                SBAR(); DSA_RESC(al1); SBAR();
                pv_half_b<1>(o, vbp, b0, b1);
                SBAR();
            }
            if (j < jmax) stage_write(S, Kl + (buf ^ 1) * SHM_T, Vl + vn * SHM_T, kws, vst0, vst1);
            __syncthreads();
            buf ^= 1; vi = vn;
        }
    } else {
        bf16x8 c0 = {}, c1 = {}, c2 = {}, c3 = {}; int vp_ = 0;
        for (; j < J1; ++j) {
            const u64 mw = mw_next; if (j < jw) mw_next = bmrow[j + 1];
            if (j < jmax) stage_load(S, Kp, Vp, (j + 1) * 64, sr, sc);
            const int vn = vi == 2 ? 0 : vi + 1;
            {
                f32x16 pA, pB; float al;
                if (j > 0) { const LAS char* vbp = Vl + vp_ * SHM_T + v_rd_base(lane);
                    SBAR(); pv_half_b<0>(o, vbp, c0, c1); pv_half_b<1>(o, vbp, c2, c3); }
                SBAR(); qkt_half<0>(pA, Kl + buf * SHM_T, r32, hi, qr); SBAR();
                qkt_half<1>(pB, Kl + buf * SHM_T, r32, hi, qr); SBAR();
                DSA_SMF2(pA, pB, c0, c1, c2, c3, al);
                SBAR(); DSA_RESC(al); SBAR();
            }
            if (j < jmax) stage_write(S, Kl + (buf ^ 1) * SHM_T, Vl + vn * SHM_T, kws, vst0, vst1);
            __syncthreads();
            buf ^= 1; vp_ = vi; vi = vn;
        }
        if (J1 > 0) { const LAS char* vbp = Vl + vp_ * SHM_T + v_rd_base(lane);
            SBAR(); pv_half_b<0>(o, vbp, c0, c1); pv_half_b<1>(o, vbp, c2, c3); SBAR(); }
    }
    for (; j <= jmax; ++j) {
        const u64 mw = mw_next; if (j < jw) mw_next = bmrow[j + 1];
        if (j < jmax) stage_load(S, Kp, Vp, (j + 1) * 64, sr, sc);
        if (j <= jw) {
            const bool nearT = (t0 + wid * 32) - (64 * j + 63) < 113;
            f32x16 pA, pB; bf16x8 a0, a1, b0, b1; float al0, al1;
            SBAR(); qkt_half<0>(pA, Kl + buf * SHM_T, r32, hi, qr);
            qkt_half<1>(pB, Kl + buf * SHM_T, r32, hi, qr);
            SBAR(); if (nearT) DSA_SMN(0, pA, a0, a1, al0); else DSA_SMF(0, pA, a0, a1, al0);
            SBAR(); DSA_RESC(al0); SBAR();
            pv_half<0>(o, vb + vi * SHM_T, a0, a1);
            SBAR(); if (nearT) DSA_SMN(1, pB, b0, b1, al1); else DSA_SMF(1, pB, b0, b1, al1);
            SBAR(); DSA_RESC(al1); SBAR();
            pv_half<1>(o, vb + vi * SHM_T, b0, b1);
            SBAR();
        }
        const int vn = vi == 2 ? 0 : vi + 1;
        if (j < jmax) stage_write(S, Kl + (buf ^ 1) * SHM_T, Vl + vn * SHM_T, kws, vst0, vst1);
        __syncthreads();
        buf ^= 1; vi = vn;
    }
#undef DSA_SMF
#undef DSA_SMF2
#undef DSA_SMN
#undef DSA_RESC
#undef SGB_MFMA_VALU
    if (hi == 0) li_l[r32] = l_reg; LDS_WAIT();
    float rli[16];
#pragma unroll
    for (int r = 0; r < 16; ++r) rli[r] = __builtin_amdgcn_rcpf(li_l[crow(r, hi)]);
#ifdef PROBE_ZERO_DS
#pragma unroll
    for (int r = 0; r < 16; ++r) rli[r] = 0.f;
#endif
#ifdef PROBE_ZERO_DS_LATE
    if (t0 >= 256) {
#pragma unroll
    for (int r = 0; r < 16; ++r) rli[r] = 0.f; }
#endif
    store_o(o, rli, Op + (size_t)(wid * 32) * PITCH, r32, hi);
    __syncthreads();
}
#undef KSWZ
}

namespace idx {
__device__ __forceinline__ unsigned fkey(float s) {
    const _Float16 hh = (_Float16)s; unsigned bits = (unsigned)__builtin_bit_cast(unsigned short, hh);
#ifdef PROBE_COARSE_KEYS
    bits &= ~(unsigned)PROBE_COARSE_KEYS;
#endif
    return (bits & 0x8000u) ? (~bits & 0xffffu) : (bits | 0x8000u);
}
template <int CTRL> __device__ __forceinline__ int dpp_mov(int v) { return __builtin_amdgcn_update_dpp(0, v, CTRL, 0xf, 0xf, false); }
__device__ __forceinline__ int wave_sum_dpp(int x) {
    x += dpp_mov<0xB1>(x); x += dpp_mov<0x4E>(x); x += dpp_mov<0x141>(x); x += dpp_mov<0x140>(x);
    return __builtin_amdgcn_readlane(x, 0) + __builtin_amdgcn_readlane(x, 16) + __builtin_amdgcn_readlane(x, 32) + __builtin_amdgcn_readlane(x, 48);
}
__device__ __forceinline__ unsigned count_ge(const u32x4 (&dat)[16], int jn, unsigned cand) {
    const unsigned cm1 = __builtin_amdgcn_readfirstlane((cand - 1u) | ((cand - 1u) << 16)), one2 = 0x00010001u;
    unsigned acc = 0u;
#pragma unroll
    for (int j = 0; j < 16; ++j) if (j < jn) {
#pragma unroll
        for (int e = 0; e < 4; ++e) { unsigned d;
            asm volatile("v_pk_sub_u16 %0, %2, %3 clamp\n\tv_pk_min_u16 %0, %0, %4\n\tv_pk_add_u16 %1, %1, %0" : "=&v"(d), "+v"(acc) : "v"(dat[j][e]), "s"(cm1), "s"(one2)); } }
    return (unsigned)wave_sum_dpp((int)(acc & 0xffffu) + (int)(acc >> 16));
}
__device__ __forceinline__ void load_af(bf16x8 (&af)[4][4], const bf16* QIX, size_t row0, int r32, int hi) {
#pragma unroll
    for (int rt = 0; rt < 4; ++rt) { const int q = 2 * rt + ((r32 >> 2) & 1), hd = (r32 & 3) + 4 * (r32 >> 3);
#pragma unroll
        for (int ks = 0; ks < 4; ++ks) af[rt][ks] = *(const bf16x8*)(QIX + (row0 + q) * WATT + hd * IDIM + ks * 16 + hi * 8); }
}
struct PrepRegs { float wv; float w16[NIH]; unsigned short q16[NIH]; };
__device__ __forceinline__ void prep_issue(PrepRegs& R, const Frame& F, const bf16* QIX, const float* WIX, size_t row0) {
    R.wv = (F.tid < 128) ? WIX[row0 * NIH + F.tid] : 0.f;
    const int q = F.tid >> 6, d = F.tid & 63;
#pragma unroll
    for (int hd = 0; hd < NIH; ++hd) { R.w16[hd] = WIX[(row0 + q) * NIH + hd]; R.q16[hd] = QIX[(row0 + q) * WATT + hd * IDIM + d]; }
}
__device__ __forceinline__ void prep_commit(const PrepRegs& R, const Frame& F, int par) {
    LAS float* WL = (LAS float*)(F.lds + EXTRA_OFF + par * 2048);
    LAS unsigned short* QL = (LAS unsigned short*)(F.lds + EXTRA_OFF + par * 2048 + 512);
    if (F.tid < 128) WL[F.tid] = R.wv;
    float a = 0.f;
#pragma unroll
    for (int hd = 0; hd < NIH; ++hd) a = fmaf(R.w16[hd], (float)__builtin_bit_cast(_Float16, R.q16[hd]), a);
    QL[(F.tid >> 6) * IDIM + (F.tid & 63)] = __builtin_bit_cast(unsigned short, (_Float16)a);
}
__device__ __forceinline__ void unit(const Frame& F, int b, int t0, bool has_next, int nb, int nt0, bf16x8 (&af)[4][4], int par, const bf16* QIX, const bf16* KIX, const float* WIX, unsigned char* BM) {
    LAS unsigned short* SC = (LAS unsigned short*)F.lds;
    const int wave = F.wave, lane = F.lane, r32 = lane & 31, hi = lane >> 5;
    const size_t rowbase = (size_t)b * SEQ;
    const int ntile = (t0 + 8 + 31) >> 5;
#ifdef PROBE_TIME
    LAS unsigned long long* TA = (LAS unsigned long long*)(F.lds + EXTRA_OFF + 6144); unsigned long long tp0 = clock64();
#define TSTAMP(k) do { const unsigned long long tn_ = clock64(); if (F.tid == 0) TA[k] += tn_ - tp0; tp0 = tn_; } while (0)
#else
#define TSTAMP(k) do {} while (0)
#endif
    __syncthreads();
    {
        LAS float* WL = (LAS float*)(F.lds + EXTRA_OFF + par * 2048);
        LAS unsigned short* QL = (LAS unsigned short*)(F.lds + EXTRA_OFF + par * 2048 + 512);
        bf16x8 af5[4];
        {   const int q5 = 2 * (r32 & 3) + ((r32 >> 2) & 1);
#pragma unroll
            for (int ks = 0; ks < 4; ++ks) { u32x4 pk = *(const LAS u32x4*)(QL + q5 * IDIM + ks * 16 + hi * 8); if (r32 >= 8) pk = (u32x4){0u, 0u, 0u, 0u}; af5[ks] = __builtin_bit_cast(bf16x8, pk); }
        }
        TSTAMP(0);
        bf16x8 bnx[4];
        if (wave < ntile) {
#pragma unroll
            for (int ks = 0; ks < 4; ++ks) bnx[ks] = *(const bf16x8*)(KIX + (rowbase + wave * 32) * IDIM + ((ks * 2 + hi) * 32 + r32) * 8); }
        for (int jt = wave; jt < ntile; jt += NWAVES) {
            const int key = jt * 32 + r32;
            bf16x8 bfr[4];
#pragma unroll
            for (int ks = 0; ks < 4; ++ks) bfr[ks] = bnx[ks];
            if (jt + NWAVES < ntile) {
#pragma unroll
                for (int ks = 0; ks < 4; ++ks) bnx[ks] = *(const bf16x8*)(KIX + (rowbase + (jt + NWAVES) * 32) * IDIM + ((ks * 2 + hi) * 32 + r32) * 8); }
            f32x16 acc5 = {};
#pragma unroll
            for (int ks = 0; ks < 4; ++ks) acc5 = MFMA32(af5[ks], bfr[ks], acc5);
            f32x16 accA = {};
#pragma unroll
            for (int ks = 0; ks < 4; ++ks) accA = MFMA32(af[0][ks], bfr[ks], accA);
#pragma unroll
            for (int rt = 0; rt < 4; ++rt) {
                f32x16 accN = {};
                if (rt < 3) {
#pragma unroll
                    for (int ks = 0; ks < 4; ++ks) accN = MFMA32(af[rt + 1][ks], bfr[ks], accN); }
                float s = acc5[rt];
                f32x4 wq4[4];
#pragma unroll
                for (int i = 0; i < 4; ++i) wq4[i] = *(const LAS f32x4*)(WL + (2 * rt + hi) * NIH + 4 * i);
#pragma unroll
                for (int r = 0; r < 16; ++r) s = fmaf(wq4[r >> 2][r & 3], fabsf(accA[r]), s);
                asm volatile("" : "+v"(s));
                const int q = 2 * rt + hi;
                const unsigned code = fkey(s);
                SC[q * 8192 + key] = (unsigned short)((key <= t0 + q) ? code : 0u);
                if (rt < 3) {
                    __builtin_amdgcn_sched_group_barrier(0x100, 4, 0);
#pragma unroll
                    for (int g_ = 0; g_ < 4; ++g_) { __builtin_amdgcn_sched_group_barrier(0x008, 1, 0); __builtin_amdgcn_sched_group_barrier(0x002, 7, 0); } }
                accA = accN;
            }
        }
    }
    TSTAMP(1);
    __syncthreads();
    TSTAMP(2);
    PrepRegs PR;
    if (has_next) { load_af(af, QIX, (size_t)nb * SEQ + nt0, r32, hi); prep_issue(PR, F, QIX, WIX, (size_t)nb * SEQ + nt0); }
    {
        const int t = t0 + wave, nch = ntile * 4, jn = (nch + 63) >> 6;
        u32x4 dat[16];
#pragma unroll
        for (int j = 0; j < 16; ++j) { const int c = j * 64 + lane; dat[j] = (c < nch) ? *(const LAS u32x4*)(SC + wave * 8192 + c * 8) : (u32x4){0u, 0u, 0u, 0u}; }
        unsigned T = 0u; int need = 0;
        if (t >= TOPK) {
            for (int bit = 15; bit >= 0; --bit) { const unsigned cand = T | (1u << bit); if (count_ge(dat, jn, cand) >= (unsigned)TOPK) T = cand; }
            const unsigned cgt = (T == 0xffffu) ? 0u : count_ge(dat, jn, T + 1u);
            need = TOPK - (int)cgt;
        }
        TSTAMP(3);
        int taken = 0;
#pragma unroll
        for (int j = 0; j < 16; ++j) if (j < jn) {
            const int c = j * 64 + lane;
            unsigned gm = 0u, tm = 0u;
#pragma unroll
            for (int i = 0; i < 8; ++i) { const unsigned k = (dat[j][i >> 1] >> (16 * (i & 1))) & 0xffffu; gm |= (k > T ? 1u : 0u) << i; tm |= (k == T ? 1u : 0u) << i; }
            unsigned byte = gm;
            if (need > taken && __any(tm != 0u)) {
                const int cnt = __builtin_popcount(tm);
                int inc = cnt;
#pragma unroll
                for (int o = 1; o < 64; o <<= 1) { const int v = __shfl_up(inc, o); if (lane >= o) inc += v; }
                const int tot = __shfl(inc, 63);
                int allow = need - taken - (inc - cnt); allow = allow < 0 ? 0 : (allow > 8 ? 8 : allow);
                unsigned tsel = 0u; int k = 0;
#pragma unroll
                for (int i = 0; i < 8; ++i) { const unsigned bt = (tm >> i) & 1u; if (bt && k < allow) tsel |= 1u << i; k += (int)bt; }
                byte |= tsel;
                taken += (tot < need - taken) ? tot : (need - taken);
            }
            {
                const unsigned w4 = (unsigned)dpp_mov<0x00>((int)byte) | ((unsigned)dpp_mov<0x55>((int)byte) << 8) | ((unsigned)dpp_mov<0xAA>((int)byte) << 16) | ((unsigned)dpp_mov<0xFF>((int)byte) << 24);
                if ((lane & 3) == 0 && c < nch) *(unsigned*)(BM + (rowbase + t) * 1024 + c) = w4; }
        }
    }
    TSTAMP(4);
    if (has_next) prep_commit(PR, F, par ^ 1);
    TSTAMP(5);
}
}


__device__ __forceinline__ void kw_gemm(const Frame& F, const bf16* H, const bf16* W, bf16* kix, float* wix, float wscale) {
    LAS float* red = (LAS float*)F.lds;
    const int wave = F.wave, lane = F.lane, rbp = wave & 1, kq = wave >> 1, fr = lane & 15, fq = lane >> 4;
    for (int blk = F.vcu; blk < MROWS / 64; blk += F.G) {
        const int row0 = blk * 64 + rbp * 32;
        f32x4 acc[2][5];
#pragma unroll
        for (int rb = 0; rb < 2; ++rb)
#pragma unroll
            for (int cb = 0; cb < 5; ++cb) acc[rb][cb] = (f32x4){0.f, 0.f, 0.f, 0.f};
        const char* hb = (const char*)(H + (size_t)row0 * DM + kq * 512); const char* wb = (const char*)(W + kq * 512);
        const unsigned lo = (unsigned)(fr * DM + fq * 8) * 2u;
        unsigned of[6];
#pragma unroll
        for (int c = 0; c < 6; ++c) { of[c] = lo + (unsigned)c * (16u * DM * 2u); asm volatile("" : "+v"(of[c])); }
        bf16x8 fb[4][7];
#define KW_LOAD(i, ks) do { fb[i][0] = *(const bf16x8*)(hb + (ks) * 64 + of[0]); fb[i][1] = *(const bf16x8*)(hb + (ks) * 64 + of[1]); \
            _Pragma("unroll") for (int cb = 0; cb < 5; ++cb) fb[i][2 + cb] = *(const bf16x8*)(wb + (ks) * 64 + of[cb]); } while (0)
        KW_LOAD(0, 0); KW_LOAD(1, 1); KW_LOAD(2, 2); KW_LOAD(3, 3);
#pragma unroll
        for (int ks = 0; ks < 16; ++ks) { const int i = ks & 3;
#pragma unroll
            for (int cb = 0; cb < 5; ++cb) {
                acc[0][cb] = __builtin_amdgcn_mfma_f32_16x16x32_f16(__builtin_bit_cast(pg8::h16x8, fb[i][2 + cb]), __builtin_bit_cast(pg8::h16x8, fb[i][0]), acc[0][cb], 0, 0, 0);
                acc[1][cb] = __builtin_amdgcn_mfma_f32_16x16x32_f16(__builtin_bit_cast(pg8::h16x8, fb[i][2 + cb]), __builtin_bit_cast(pg8::h16x8, fb[i][1]), acc[1][cb], 0, 0, 0); }
            SBAR();
            if (ks + 4 < 16) KW_LOAD(i, ks + 4);
            SBAR();
        }
#undef KW_LOAD
        __syncthreads();
#pragma unroll
        for (int rb = 0; rb < 2; ++rb)
#pragma unroll
            for (int cb = 0; cb < 5; ++cb) *(LAS f32x4*)(red + ((((kq * 2 + rbp) * 10 + rb * 5 + cb) * 64 + lane) * 4)) = acc[rb][cb];
        __syncthreads();
#pragma unroll
        for (int rb = 0; rb < 2; ++rb)
#pragma unroll
            for (int c = 0; c < 2; ++c) { const int cb = 2 * kq + c;
                if (cb < 5) { f32x4 v = {0.f, 0.f, 0.f, 0.f};
#pragma unroll
                    for (int q = 0; q < 4; ++q) v += *(const LAS f32x4*)(red + ((((q * 2 + rbp) * 10 + rb * 5 + cb) * 64 + lane) * 4));
                    const size_t row = (size_t)(row0 + rb * 16 + fr);
                    if (cb < 4) { u32x2 w2; w2.x = cvtpk(v[0], v[1]); w2.y = cvtpk(v[2], v[3]);
                        *(u32x2*)(kix + (row >> 5) * 2048 + ((cb * 2 + (fq >> 1)) * 32 + (row & 31)) * 8 + (fq & 1) * 4) = w2; }
                    else *(f32x4*)(wix + row * 16 + fq * 4) = v * wscale; } }
    }
}

__device__ __forceinline__ void conv_fixup(const Frame& F, const float* ghalo, const float* gdef, const float* udef, const float* convw, const float* convb, bf16* act) {
    const int nth = F.G * NWAVES * 64, gt = F.vcu * NWAVES * 64 + F.tid;
    for (int id = gt; id < 512 * (FF / 4); id += nth) {
        const int rowi = id / (FF / 4), f = 4 * (id % (FF / 4)), blk = rowi >> 1, i = rowi & 1;
        const bool first = (blk & 127) == 0;
        const f32x4 z = {0.f, 0.f, 0.f, 0.f};
        const f32x4 g = *(const f32x4*)(gdef + (size_t)rowi * FF + f), u = *(const f32x4*)(udef + (size_t)rowi * FF + f);
        f32x4 g1, g2;
        if (i == 0) { g1 = first ? z : *(const f32x4*)(ghalo + (size_t)((blk - 1) * 2 + 1) * FF + f); g2 = first ? z : *(const f32x4*)(ghalo + (size_t)((blk - 1) * 2) * FF + f); }
        else { g1 = *(const f32x4*)(gdef + (size_t)(blk * 2) * FF + f); g2 = first ? z : *(const f32x4*)(ghalo + (size_t)((blk - 1) * 2 + 1) * FF + f); }
        const f32x4 w0 = *(const f32x4*)(convw + f), w1 = *(const f32x4*)(convw + FF + f), w2 = *(const f32x4*)(convw + 2 * FF + f), cb = *(const f32x4*)(convb + f);
        f32x4 r;
#pragma unroll
        for (int e = 0; e < 4; ++e) { const float a = cb[e] + w0[e] * g2[e] + w1[e] * g1[e] + w2[e] * g[e]; r[e] = a * pg8::sigmoidf_fast(a) * u[e]; }
        u32x2 w; w.x = cvtpk(r[0], r[1]); w.y = cvtpk(r[2], r[3]);
        *(u32x2*)(act + (size_t)(blk * 64 + i) * FF + f) = w;
    }
}

struct Args { const float* in[17]; float* out; unsigned char* ws; int ph_lo, ph_hi; };
__global__ void __launch_bounds__(NWAVES * 64, 2) mk_fwd(Args args) {
    extern __shared__ __attribute__((aligned(16))) unsigned char lds[];
#define FRAME(F) Frame F; { int l_; asm volatile("v_mbcnt_lo_u32_b32 %0, -1, 0\n\tv_mbcnt_hi_u32_b32 %0, -1, %0" : "=v"(l_)); F.lds = (LAS unsigned char*)lds; F.MISC = (volatile LAS unsigned*)(F.lds + MISC_OFF); \
        F.wave = wave0; F.lane = l_; F.tid = wave0 * 64 + l_; F.G = gridDim.x; const int bx_ = blockIdx.x; F.vcu = (F.G % 8 == 0) ? (bx_ % 8) * (F.G / 8) + bx_ / 8 : bx_; }
    const int wave0 = __builtin_amdgcn_readfirstlane((int)threadIdx.x >> 6);
    FRAME(F0);
    unsigned char* ws = args.ws;
    gu32* ctl = (gu32*)(ws + WS_CTL);
    for (int u = F0.tid; u < (LDS_BYTES - LDSCTL_OFF) / 4; u += NWAVES * 64) ((LAS unsigned*)(F0.lds + LDSCTL_OFF))[u] = 0u;
    __syncthreads();
    if (N_LAUNCHES == 1) (void)xcd_barrier_post((unsigned*)(ctl + CW_BAR), F0.MISC + 8, F0.tid == 0);
#define GRID_BAR() do { if (N_LAUNCHES == 1) { XcdBarrier b_; b_.bar = (unsigned*)((gu32*)(ws + WS_CTL) + CW_BAR); b_.x = xb_xcc_id(); b_.st = F.MISC + 8; xcd_barrier(b_, F.tid == 0); } } while (0)
    const int lo = (N_LAUNCHES == 1) ? 0 : args.ph_lo, hi = (N_LAUNCHES == 1) ? NPH : args.ph_hi;
#ifndef PH_MASK
#define PH_MASK 0xfff
#endif
#define IN(k) (((PH_MASK >> (k)) & 1) && lo <= (k) && (k) < hi)
#define BOTH(k) ((IN(k) && IN((k) + 1)) || rep_ + 1 < DUPN(k))
#ifdef PROBE_GEMM_TIME
#define GEMM_TSTAT ((LAS unsigned long long*)(F.lds + EXTRA_OFF + 4096) + 2 * gphase_++)
#else
#define GEMM_TSTAT nullptr
#endif
#ifdef PROBE_DUP
#define DUPN(k) ((k) == PROBE_DUP ? 2 : 1)
#define DUPOUT(k, real) ((PROBE_DUP == (k) && rep_ == 0) ? (bf16*)(w + WS_H) : (real))
#else
#define DUPN(k) 1
#define DUPOUT(k, real) (real)
#endif

    float* out = args.out;
#ifdef PROBE_PHASE_TIME
    const unsigned long long tk0_ = clock64(); unsigned long long tpa_ = 0ull, tpb_ = 0ull;
#endif
#ifdef PROBE_GEMM_TIME
    int gphase_ = 0;
    if (F0.tid < 16) ((LAS unsigned long long*)(F0.lds + EXTRA_OFF + 4096))[F0.tid] = 0ull;
    __syncthreads();
#endif
#define WSP(name) size_t zo_ = 0; int zq = 0; asm volatile("" : "+s"(zo_), "+s"(zq)); unsigned char* name = ws + zo_; FRAME(F)
#define MODP(w) ((float*)((w) + WS_MOD))
#define SEGP(w, i) ((bf16*)((w) + WS_SEG) + (size_t)(i) * (SEG_BYTES / 2))

    for (int rep_ = 0; rep_ < DUPN(0); ++rep_) if (IN(0)) { WSP(w);
        ph0_mod(F, args.in[1 + zq], args.in[2 + zq], args.in[3 + zq], MODP(w));
#ifdef PROBE_DUP_MOD_ONLY
        if (rep_ == 0) { GRID_BAR(); continue; }
#endif
        WPtrs P{args.in[5 + zq], args.in[6 + zq], args.in[7 + zq], args.in[8 + zq], args.in[11 + zq], args.in[12 + zq], args.in[15 + zq], (bf16*)(w + WS_WIN), (bf16*)(w + WS_WOSB), (bf16*)(w + WS_WODS), (bf16*)(w + WS_WOUT), (bf16*)(w + WS_WGU), (bf16*)(w + WS_WDN)};
        ph0_weights(F, P, 0, F.vcu, F.G);
#ifdef WEIGHTS_ALL_IN_P0
        __syncthreads(); ph0_weights(F, P, 1, F.vcu, F.G);
#endif
        if (BOTH(0)) GRID_BAR();
    }
    for (int rep_ = 0; rep_ < DUPN(1); ++rep_) if (IN(1)) { WSP(w); norm_mod_rows<0>(F, args.in[0 + zq], (bf16*)(w + WS_D1), (bf16*)(w + WS_H), (unsigned char*)out + OUT_H8, (float*)(w + WS_SA1), args.in[4 + zq], MODP(w) + 0 * DM, MODP(w) + 1 * DM);
        {
            GAS u32x4* z = (GAS u32x4*)(w + WS_BM); const int n16 = (int)((size_t)MROWS * 1024 / 16);
            for (int i = F.vcu * (NWAVES * 64) + F.tid; i < n16; i += F.G * NWAVES * 64) z[i] = (u32x4){0u, 0u, 0u, 0u}; }
        if (BOTH(1)) GRID_BAR(); }
    for (int rep_ = 0; rep_ < DUPN(2); ++rep_) if (IN(2)) {
      { WSP(w);
        pg8::Gemm g{(bf16*)(w + WS_H), (bf16*)(w + WS_WIN), (bf16*)(w + WS_H), (bf16*)(w + WS_WIN), DM}; pg8::TileOrder S; S.init(MROWS / 256, 12, 1, F.G, (int)blockIdx.x);
        pg8::EpiIn E{SEGP(w, 0), SEG_BYTES / 2, (unsigned char*)out, (bf16*)(w + WS_KIX), (float*)(w + WS_WIX), 0.25f * 0.125f};
        pg8::gemm_phase<pg8::EpiIn, pg8::TileOrder, true, true>(F.lds + RING_OFF, g, S, E, F.tid, GEMM_TSTAT);
      }
        {   WSP(w);
            __syncthreads();
            pg8::Gemm g8{(bf16*)((unsigned char*)out + OUT_H8), (bf16*)(w + WS_WG8), (bf16*)((unsigned char*)out + OUT_H8), (bf16*)(w + WS_WG8), DM / 2}; pg8::TileOrder S8; S8.init(MROWS / 256, 32, 1, F.G, (int)blockIdx.x);
            pg8::EpiGate E8{(unsigned char*)out, (const float*)(w + WS_SA1), SEGP(w, 2), SEG_BYTES / 2};
            pg8::gemm_phase<pg8::EpiGate, pg8::TileOrder, true, true, false, true>(F.lds + RING_OFF, g8, S8, E8, F.tid, nullptr);
            __syncthreads(); }
      { WSP(w);
        kw_gemm(F, (const bf16*)(w + WS_H), (const bf16*)(w + WS_WIN) + (size_t)44 * 256 * DM, (bf16*)(w + WS_KIX), (float*)(w + WS_WIX), 0.25f * 0.125f);
#ifndef WEIGHTS_ALL_IN_P0
        {
            const int nunits = (MROWS / 256) * (N_IN_PAD / 256), full = nunits / F.G, extra = nunits - full * F.G;
            const int bx = (int)blockIdx.x;
            WPtrs P{args.in[5 + zq], args.in[6 + zq], args.in[7 + zq], args.in[8 + zq], args.in[11 + zq], args.in[12 + zq], args.in[15 + zq], (bf16*)(w + WS_WIN), (bf16*)(w + WS_WOSB), (bf16*)(w + WS_WODS), (bf16*)(w + WS_WOUT), (bf16*)(w + WS_WGU), (bf16*)(w + WS_WDN)};
            if (extra == 0 || extra >= F.G) ph0_weights(F, P, 1, bx, F.G);
            else if (bx >= extra) ph0_weights(F, P, 1, bx - extra, F.G - extra);
        }
#endif
      }
        if (BOTH(2)) { FRAME(F); GRID_BAR(); }
    }
    for (int rep_ = 0; rep_ < DUPN(3); ++rep_) if (IN(3)) { WSP(w);
#if defined(PROBE_PHASE_TIME) && PROBE_PHASE_TIME == 0
        tpa_ = clock64();
#endif
#ifdef PROBE_DUP_IDX_ONLY
        if (rep_ == DUPN(3) - 1)
#endif
        for (int u = F.vcu; u < 2 * NHEAD * 32; u += F.G) { const int bh = u >> 5, qb = u & 31; att::sb_block(F, bh >> 3, bh & 7, qb, SEGP(w, 0), SEGP(w, 1), SEGP(w, 2), DUPOUT(3, SEGP(w, 0))); }
#ifdef PROBE_TIME
        if (F.tid < 8) ((LAS unsigned long long*)(F.lds + EXTRA_OFF + 6144))[F.tid] = 0ull;
        __syncthreads();
#endif
#if defined(PROBE_PHASE_TIME) && PROBE_PHASE_TIME == 0
        tpb_ = clock64();
#endif
#if defined(PROBE_PHASE_TIME) && PROBE_PHASE_TIME == 1
        tpa_ = clock64();
#endif
        {   const int NU = BATCH * SEQ / 8, nit = (NU + F.G - 1) / F.G;
#define IDX_ID(i) ((i) * F.G + (((i) & 1) ? (F.G - 1 - F.vcu) : F.vcu))
            const bf16* QIXp = SEGP(w, 6); const bf16* KIXp = (const bf16*)(w + WS_KIX); const float* WIXp = (const float*)(w + WS_WIX);
            bf16x8 af[4][4]; int i = 0;
            while (i < nit && IDX_ID(i) >= NU) ++i;
            if (i < nit) { const int id = IDX_ID(i); const size_t row0 = (size_t)(id & 1) * SEQ + (size_t)(id >> 1) * 8;
                idx::load_af(af, QIXp, row0, F.lane & 31, F.lane >> 5); idx::PrepRegs PR; idx::prep_issue(PR, F, QIXp, WIXp, row0); idx::prep_commit(PR, F, 0); }
            int par = 0;
            while (i < nit) { const int id = IDX_ID(i); int inx = i + 1; while (inx < nit && IDX_ID(inx) >= NU) ++inx;
                const bool hn = inx < nit; const int idn = hn ? IDX_ID(inx) : id;
                idx::unit(F, id & 1, (id >> 1) * 8, hn, idn & 1, (idn >> 1) * 8, af, par, QIXp, KIXp, WIXp, w + WS_BM);
                par ^= 1; i = inx; }
            __syncthreads();
#undef IDX_ID
        }
#if defined(PROBE_PHASE_TIME) && PROBE_PHASE_TIME == 1
        tpb_ = clock64();
#endif
#ifdef PROBE_TIME
        if (blockIdx.x == 0 && F.tid == 0) { LAS unsigned long long* TA = (LAS unsigned long long*)(F.lds + EXTRA_OFF + 6144); float tot = 0.f; for (int k = 0; k < 6; ++k) tot += (float)TA[k];
            ((float*)(w + WS_MOD))[2 * 6 * DM] = floorf((float)TA[PROBE_TIME] / tot * 20.f + 0.5f) * 0.05f; }
#endif
        if (BOTH(3)) GRID_BAR();
    }
    for (int rep_ = 0; rep_ < DUPN(4); ++rep_) if (IN(4)) { WSP(w);
#ifdef PROBE_DELAY4
        for (int d_ = 0; d_ < 10; ++d_) __builtin_amdgcn_s_sleep(127);
#endif
#if defined(PROBE_PHASE_TIME) && PROBE_PHASE_TIME == 2
        tpa_ = clock64();
#endif
        for (int it = F.vcu; it < 2 * NHEAD * 16; it += F.G) { const int bh = it >> 4, p = it & 15;
            att::dsa_block(F, bh >> 3, bh & 7, 31 - p, SEGP(w, 3), SEGP(w, 4), SEGP(w, 5), DUPOUT(4, SEGP(w, 3)), (const u64*)(w + WS_BM), args.in[9 + zq]);
            att::dsa_block(F, bh >> 3, bh & 7, p, SEGP(w, 3), SEGP(w, 4), SEGP(w, 5), DUPOUT(4, SEGP(w, 3)), (const u64*)(w + WS_BM), args.in[9 + zq]); }
#if defined(PROBE_PHASE_TIME) && PROBE_PHASE_TIME == 2
        tpb_ = clock64();
#endif
        if (BOTH(4)) GRID_BAR();
    }
    for (int rep_ = 0; rep_ < DUPN(5); ++rep_) if (IN(5)) { WSP(w);
        pg8::Gemm g{SEGP(w, 0), (bf16*)(w + WS_WOSB), SEGP(w, 3), (bf16*)(w + WS_WODS), WATT}; pg8::TileOrder S; S.init(MROWS / 256, DM / 256, 2, F.G, (int)blockIdx.x);
        pg8::EpiMerged E{(const unsigned char*)out, (bf16*)(w + WS_H)};
        pg8::gemm_phase<pg8::EpiMerged, pg8::TileOrder, true, true>(F.lds + RING_OFF, g, S, E, F.tid, GEMM_TSTAT);
        if (BOTH(5)) GRID_BAR();
    }
    for (int rep_ = 0; rep_ < DUPN(6); ++rep_) if (IN(6)) { WSP(w);
        pg8::Gemm g{(bf16*)(w + WS_H), (bf16*)(w + WS_WOUT), (bf16*)(w + WS_H), (bf16*)(w + WS_WOUT), DM / 2}; pg8::TileOrder S; S.init(MROWS / 256, DM / 256, 1, F.G, (int)blockIdx.x);
        pg8::EpiDelta<true, true> E{(bf16*)(w + WS_D1), MODP(w) + 2 * DM, 6 * DM};
        pg8::gemm_phase<pg8::EpiDelta<true, true>, pg8::TileOrder, true, true, false, true>(F.lds + RING_OFF, g, S, E, F.tid, GEMM_TSTAT);
        if (BOTH(6)) GRID_BAR();
    }
    for (int rep_ = 0; rep_ < DUPN(7); ++rep_) if (IN(7)) { WSP(w); norm_mod_rows<2>(F, (const bf16*)(w + WS_D1), nullptr, (bf16*)(w + WS_H), nullptr, (float*)(w + WS_SA), args.in[10 + zq], MODP(w) + 3 * DM, MODP(w) + 4 * DM); if (BOTH(7)) GRID_BAR(); }
    for (int rep_ = 0; rep_ < DUPN(8); ++rep_) if (IN(8)) { WSP(w);
        pg8::Gemm g{(bf16*)(w + WS_H), (bf16*)(w + WS_WGU), (bf16*)(w + WS_H), (bf16*)(w + WS_WGU), DM / 2}; pg8::TileOrder S; S.init(MROWS / 256, 2 * FF / 256, 1, F.G, (int)blockIdx.x);
        pg8::EpiGU<true> E{(bf16*)(w + WS_ACT), (float*)(w + WS_GHALO), (float*)(w + WS_GDEF), (float*)(w + WS_UDEF), args.in[13 + zq], args.in[14 + zq], (const float*)(w + WS_SA)};
        pg8::gemm_phase<pg8::EpiGU<true>, pg8::TileOrder, true, true, false, true>(F.lds + RING_OFF, g, S, E, F.tid, GEMM_TSTAT);
        if (BOTH(8)) GRID_BAR();
    }
    for (int rep_ = 0; rep_ < DUPN(9); ++rep_) if (IN(9)) { WSP(w); conv_fixup(F, (const float*)(w + WS_GHALO), (const float*)(w + WS_GDEF), (const float*)(w + WS_UDEF), args.in[13 + zq], args.in[14 + zq], (bf16*)(w + WS_ACT)); if (BOTH(9)) GRID_BAR(); }
#ifndef PROBE_ZERO_FFN
    for (int rep_ = 0; rep_ < DUPN(10); ++rep_) if (IN(10)) { WSP(w);
        pg8::Gemm g{(bf16*)(w + WS_ACT), (bf16*)(w + WS_WDN), (bf16*)(w + WS_ACT), (bf16*)(w + WS_WDN), FF}; pg8::TileOrder S; S.init(MROWS / 256, DM / 256, 1, F.G, (int)blockIdx.x);
        pg8::EpiDelta<false> E{(bf16*)(w + WS_H), MODP(w) + 5 * DM, 6 * DM};
        pg8::gemm_phase<pg8::EpiDelta<false>, pg8::TileOrder, true, true>(F.lds + RING_OFF, g, S, E, F.tid, GEMM_TSTAT);
        if (BOTH(10)) GRID_BAR();
    }
#endif
    if (IN(11)) { int zq = 0; asm volatile("" : "+s"(zq)); FRAME(F); norm_final_rows(F, (const bf16*)(ws + WS_D1), (const bf16*)(ws + WS_H), out, args.in[16 + zq]);
#ifdef PROBE_PHASE_TIME
        { if (blockIdx.x == 0 && F.tid == 0) ((float*)(ws + WS_MOD))[2 * 6 * DM + 2] = floorf((float)(tpb_ - tpa_) / (float)(clock64() - tk0_) * 40.f + 0.5f) * 0.025f;
          GRID_BAR();
          const float m = 1.0f + ((const float*)(ws + WS_MOD))[2 * 6 * DM + 2]; const int gw = F.vcu * NWAVES + F.wave, NGW = F.G * NWAVES;
          for (int row = gw; row < MROWS; row += NGW) { GAS f32x4* xr = (GAS f32x4*)(out + (size_t)row * DM) + F.lane; for (int j = 0; j < 8; ++j) xr[64 * j] = xr[64 * j] * m; } }
#endif
#ifdef PROBE_GEMM_TIME
        { LAS unsigned long long* ts_ = (LAS unsigned long long*)(F.lds + EXTRA_OFF + 4096) + 2 * PROBE_GEMM_TIME;
          if (blockIdx.x == 0 && F.tid == 0) ((float*)(ws + WS_MOD))[2 * 6 * DM + 1] = floorf((float)ts_[0] / (float)ts_[1] * 50.f + 0.5f) * 0.02f;
          GRID_BAR();
          const float m = 1.0f + ((const float*)(ws + WS_MOD))[2 * 6 * DM + 1]; const int gw = F.vcu * NWAVES + F.wave, NGW = F.G * NWAVES;
          for (int row = gw; row < MROWS; row += NGW) { GAS f32x4* xr = (GAS f32x4*)(out + (size_t)row * DM) + F.lane; for (int j = 0; j < 8; ++j) xr[64 * j] = xr[64 * j] * m; } }
#endif
#ifdef PROBE_TIME
        { const float m = 1.0f + ((const float*)(ws + WS_MOD))[2 * 6 * DM]; __syncthreads(); VM_WAIT(); const int gw = F.vcu * NWAVES + F.wave, NGW = F.G * NWAVES;
          for (int row = gw; row < MROWS; row += NGW) { GAS f32x4* xr = (GAS f32x4*)(out + (size_t)row * DM) + F.lane; for (int j = 0; j < 8; ++j) xr[64 * j] = xr[64 * j] * m; } }
#endif
    }
#undef IN
#undef BOTH
#undef GRID_BAR
}

extern "C" void kernel_launch(void* const* d_in, const int* in_sizes, int n_in, void* d_out, int out_size, void* d_ws, size_t ws_size, hipStream_t stream) {
    static int grid = 0;
    if (grid == 0) {
        if (n_in != 17 || in_sizes[0] != MROWS * DM || out_size != MROWS * DM || ws_size < WS_END) { fprintf(stderr, "kernel_launch: unexpected shapes (n_in %d, in0 %d, out %d, ws %zu); nothing launched\n", n_in, n_in > 0 ? in_sizes[0] : -1, out_size, ws_size); grid = -1; return; }
        int dev = 0, cus = 0, per_cu = 0;
        if (hipGetDevice(&dev) != hipSuccess || hipDeviceGetAttribute(&cus, hipDeviceAttributeMultiprocessorCount, dev) != hipSuccess) { grid = -1; return; }
        if (hipFuncSetAttribute((const void*)mk_fwd, hipFuncAttributeMaxDynamicSharedMemorySize, LDS_BYTES) != hipSuccess) { fprintf(stderr, "kernel_launch: hipFuncSetAttribute failed\n"); grid = -1; return; }
        if (hipOccupancyMaxActiveBlocksPerMultiprocessor(&per_cu, (const void*)mk_fwd, NWAVES * 64, LDS_BYTES) != hipSuccess || per_cu < 1)
            fprintf(stderr, "kernel_launch: note: occupancy query reports %d workgroups per CU\n", per_cu);
        (void)hipGetLastError();
        grid = cus;
    }
    if (grid < 0) return;
    if (hipMemsetAsync((char*)d_ws + WS_CTL, 0, ZERO_BYTES, stream) != hipSuccess) { fprintf(stderr, "kernel_launch: memset failed\n"); return; }
    Args a{};
    for (int i = 0; i < 17; ++i) a.in[i] = (const float*)d_in[i];
    a.out = (float*)d_out; a.ws = (unsigned char*)d_ws;
    for (int li = 0; li < N_LAUNCHES; ++li) {
        a.ph_lo = (N_LAUNCHES == 1) ? 0 : li; a.ph_hi = (N_LAUNCHES == 1) ? NPH : li + 1;
        hipLaunchKernelGGL(mk_fwd, dim3(grid), dim3(NWAVES * 64), LDS_BYTES, stream, a);
        const hipError_t le = hipPeekAtLastError();
        if (le != hipSuccess) { fprintf(stderr, "kernel_launch: launch %d failed: %s\n", li, hipGetErrorName(le)); break; }
    }
}
```
